# Optimizing an MI355X kernel written in HIP

```python
import jax, jax.numpy as jnp
from jax import lax
import numpy as np

D_MODEL = 1024
BATCH = 32
SEQ = 256
DEPTH = 4
DEC_BATCH = 4
DEC_SEQ = 2048
PAST_LEN = 256

GRID_W = 64
D_MIX = D_MODEL
WA = D_MIX // 2
HEAD_A = 64
HA = WA // HEAD_A
WB = D_MIX - WA
HB = 8
BW = WB // HB
R_W = 64
R_A = 64
R_G = 128
D_FF = 2816
CONV_B = 4
CONV_B_LEFT = 2
CONV_F = 3
CONV_F_LEFT = 1
LRU_C = 8.0
N_DIR = 2
EPS = 1e-6
LNX_EPS = 64e-5
KK_EPS = 1e-12
DECAY_SCALE = 0.6065306597126334
P_IN = 3 * WA + R_W + R_A + R_G + 2 * WB
SPLITS = (WA, 2 * WA, 3 * WA, 3 * WA + R_W, 3 * WA + R_W + R_A, 3 * WA + R_W + R_A + R_G,
          3 * WA + R_W + R_A + R_G + WB)

kernel_name = 'hybrid_rwkv7_rglru_prefix_diffusion_step'


def rmsnorm(x, g):
    xf = x.astype(jnp.float32)
    y = xf * lax.rsqrt(jnp.mean(xf * xf, axis=-1, keepdims=True) + EPS)
    return (y * g.astype(jnp.float32)).astype(x.dtype)


def dwconv(x, w, b, left, grid):
    bsz, L, C = x.shape
    K = w.shape[0]
    if grid:
        rows = L // GRID_W
        x = x.reshape(bsz * rows, GRID_W, C)
    n = x.shape[1]
    xp = jnp.pad(x, ((0, 0), (left, K - 1 - left), (0, 0)))
    y = b + xp[:, 0:n, :] * w[0]
    for j in range(1, K):
        y = y + xp[:, j:j + n, :] * w[j]
    return y.reshape(bsz, L, C)


def _heads(t):
    return t.reshape(t.shape[:-1] + (HA, HEAD_A))


def dir_time_major(x2):
    x2 = jnp.stack([x2[0], jnp.flip(x2[1], axis=1)])
    return jnp.moveaxis(x2, 2, 0)


def merge_dirs(y):
    y = jnp.moveaxis(y, 0, 2)
    return y[0] + jnp.flip(y[1], axis=1)


def _wkv7_step(S, inp):
    r_t, w_t, kk_t, b_t, k_t, v_t = inp
    sa = jnp.einsum('dbhij,dbhj->dbhi', S, kk_t)
    S = S * w_t[..., None, :] - sa[..., :, None] * b_t[..., None, :] + v_t[..., :, None] * k_t[..., None, :]
    y = jnp.einsum('dbhij,dbhj->dbhi', S, r_t)
    return S, y


def rwkv7_mix(r, k, v, xw, xa, xg, s0, w0, w_up, a0, a_up, g_up, k_k, k_a, r_k, lnx_g, lnx_b):
    bsz, T, _ = r.shape
    dt = r.dtype
    f32 = jnp.float32
    r, k, v = r.astype(f32), k.astype(f32), v.astype(f32)
    logit_w = w0[:, None, None, :] + jnp.einsum('btr,drc->dbtc', jnp.tanh(xw), w_up)
    decay = jnp.exp(-DECAY_SCALE * jax.nn.sigmoid(logit_w.astype(f32)))
    a = jax.nn.sigmoid((a0[:, None, None, :] + jnp.einsum('btr,drc->dbtc', xa, a_up)).astype(f32))
    g = jax.nn.sigmoid(xg) @ g_up
    kk = _heads(k * k_k)
    kk = kk * lax.rsqrt(jnp.sum(kk * kk, axis=-1, keepdims=True) + KK_EPS)
    k_dir = k[None] * (1.0 + (a - 1.0) * k_a)
    rh, vh, kdh = _heads(r), _heads(v), _heads(k_dir)
    both = lambda t: jnp.broadcast_to(t, (N_DIR,) + t.shape)
    xs = (dir_time_major(both(rh)), dir_time_major(_heads(decay)), dir_time_major(both(kk)),
          dir_time_major(both(kk) * _heads(a)), dir_time_major(kdh), dir_time_major(both(vh)))
    s_fin, y = lax.scan(_wkv7_step, s0.astype(f32), xs)
    o = merge_dirs(y)
    mu = jnp.mean(o, axis=-1, keepdims=True)
    var = jnp.mean(jnp.square(o - mu), axis=-1, keepdims=True)
    o = ((o - mu) * lax.rsqrt(var + LNX_EPS)).reshape(bsz, T, WA) * lnx_g + lnx_b
    bonus = jnp.sum(rh[None] * kdh * r_k, axis=(0, -1))[..., None] * vh
    out = (o + bonus.reshape(bsz, T, WA)) * g
    return out.astype(dt), s_fin


def _lin_combine(e1, e2):
    a1, b1 = e1
    a2, b2 = e2
    return a1 * a2, a2 * b1 + b2


def rglru_mix(xb, gb, h0, conv_w, conv_b, ga_w, ga_b, gx_w, gx_b, lam, grid):
    bsz, T, _ = xb.shape
    f32 = jnp.float32
    xc = dwconv(xb, conv_w, conv_b, CONV_B_LEFT, grid)
    xh = xc.reshape(bsz, T, HB, BW)
    rg = jax.nn.sigmoid((jnp.einsum('bthi,dhij->dbthj', xh, ga_w).reshape(N_DIR, bsz, T, WB)
                         + ga_b[:, None, None, :]).astype(f32))
    ig = jax.nn.sigmoid((jnp.einsum('bthi,dhij->dbthj', xh, gx_w).reshape(N_DIR, bsz, T, WB)
                         + gx_b[:, None, None, :]).astype(f32))
    log_a = -LRU_C * rg * jax.nn.softplus(-lam.astype(f32))[:, None, None, :]
    a = jnp.exp(log_a)
    u = jnp.sqrt(-jnp.expm1(2.0 * log_a)) * (ig * xc.astype(f32)[None])
    a_t = dir_time_major(a)
    u_t = dir_time_major(u)
    u_t = u_t.at[0].add(a_t[0] * h0.astype(f32))
    _, h = lax.associative_scan(_lin_combine, (a_t, u_t), axis=0)
    y = merge_dirs(h).astype(xb.dtype) * jax.nn.gelu(gb)
    return y, h[-1]


def block(x, cvec, s0, h0, grid, lp):
    mod = (jax.nn.silu(cvec) @ lp['w_mod'] + lp['b_mod'])[..., None, :]
    sh1, sc1, g1, sh2, sc2, g2 = jnp.split(mod, 6, axis=-1)
    h = rmsnorm(x, lp['ln1_g']) * (1.0 + sc1) + sh1
    proj = h @ lp['w_in']
    r, k, v, xw, xa, xg, xb, gb = jnp.split(proj, SPLITS, axis=-1)
    ya, s_fin = rwkv7_mix(r, k, v, xw, xa, xg, s0, lp['rw_w0'], lp['rw_w_up'], lp['rw_a0'], lp['rw_a_up'],
                          lp['rw_g_up'], lp['rw_k_k'], lp['rw_k_a'], lp['rw_r_k'], lp['rw_lnx_g'], lp['rw_lnx_b'])
    yb, h_fin = rglru_mix(xb, gb, h0, lp['lru_conv_w'], lp['lru_conv_b'], lp['lru_ga_w'], lp['lru_ga_b'],
                          lp['lru_gx_w'], lp['lru_gx_b'], lp['lru_lam'], grid)
    x = x + g1 * (jnp.concatenate([ya, yb], axis=-1) @ lp['w_out'])
    h = rmsnorm(x, lp['ln2_g']) * (1.0 + sc2) + sh2
    u = dwconv(h @ lp['w_up'], lp['ffn_conv_w'], lp['ffn_conv_b'], CONV_F_LEFT, grid)
    ua, ub = jnp.split(u, 2, axis=-1)
    x = x + g2 * ((jax.nn.gelu(ua) * ub) @ lp['w_down'])
    return x, s_fin, h_fin


def setup_inputs(seed: int = 0) -> dict:
    key = jax.random.key(seed)
    ks = iter(jax.random.split(key, 40))
    f32 = jnp.float32
    nrm = lambda shape, s: jax.random.normal(next(ks), shape, f32) * s
    L, D = DEPTH, D_MODEL
    x_prompt = nrm((BATCH, SEQ, D), 1.0)
    x_sample = nrm((DEC_BATCH, DEC_SEQ, D), 1.0)
    state_rwkv = nrm((DEC_BATCH, DEPTH, N_DIR, HA, HEAD_A, HEAD_A), 1.0)
    state_lru = nrm((DEC_BATCH, DEPTH, N_DIR, WB), 1.0)
    c = nrm((DEC_BATCH, D), 1.0)
    c_ctx = nrm((D,), 1.0)
    ln1_g = 1.0 + nrm((L, D), 0.02)
    w_mod = nrm((L, D, 6 * D), 0.5 * D ** -0.5)
    b_mod = nrm((L, 6 * D), 0.02)
    w_in = nrm((L, D, P_IN), D ** -0.5)
    rw_w0 = jax.random.uniform(next(ks), (L, N_DIR, WA), f32, -4.0, 2.0)
    rw_w_up = nrm((L, N_DIR, R_W, WA), 0.5 * R_W ** -0.5)
    rw_a0 = nrm((L, N_DIR, WA), 0.5)
    rw_a_up = nrm((L, N_DIR, R_A, WA), R_A ** -0.5)
    rw_g_up = nrm((L, R_G, WA), R_G ** -0.5)
    rw_k_k = 0.85 + nrm((L, WA), 0.1)
    rw_k_a = 1.0 + nrm((L, WA), 0.1)
    rw_r_k = nrm((L, HA, HEAD_A), 0.1)
    rw_lnx_g = 1.0 + nrm((L, WA), 0.02)
    rw_lnx_b = nrm((L, WA), 0.02)
    lru_conv_w = nrm((L, CONV_B, WB), CONV_B ** -0.5)
    lru_conv_b = nrm((L, WB), 0.02)
    lru_ga_w = nrm((L, N_DIR, HB, BW, BW), BW ** -0.5)
    lru_ga_b = nrm((L, N_DIR, WB), 0.02)
    lru_gx_w = nrm((L, N_DIR, HB, BW, BW), BW ** -0.5)
    lru_gx_b = nrm((L, N_DIR, WB), 0.02)
    a_pow = jax.random.uniform(next(ks), (L, N_DIR, WB), f32, 0.9, 0.999)
    p = a_pow ** (1.0 / LRU_C)
    lru_lam = jnp.log(p) - jnp.log1p(-p)
    w_out = nrm((L, D_MIX, D), D_MIX ** -0.5)
    ln2_g = 1.0 + nrm((L, D), 0.02)
    w_up = nrm((L, D, 2 * D_FF), D ** -0.5)
    ffn_conv_w = nrm((L, CONV_F, 2 * D_FF), CONV_F ** -0.5)
    ffn_conv_b = nrm((L, 2 * D_FF), 0.02)
    w_down = nrm((L, D_FF, D), D_FF ** -0.5)
    lnf_g = 1.0 + nrm((D,), 0.02)
    return {'x_prompt': x_prompt, 'x_sample': x_sample, 'state_rwkv': state_rwkv, 'state_lru': state_lru,
            'c': c, 'c_ctx': c_ctx, 'ln1_g': ln1_g, 'w_mod': w_mod, 'b_mod': b_mod, 'w_in': w_in,
            'rw_w0': rw_w0, 'rw_w_up': rw_w_up, 'rw_a0': rw_a0, 'rw_a_up': rw_a_up, 'rw_g_up': rw_g_up,
            'rw_k_k': rw_k_k, 'rw_k_a': rw_k_a, 'rw_r_k': rw_r_k, 'rw_lnx_g': rw_lnx_g, 'rw_lnx_b': rw_lnx_b,
            'lru_conv_w': lru_conv_w, 'lru_conv_b': lru_conv_b, 'lru_ga_w': lru_ga_w, 'lru_ga_b': lru_ga_b,
            'lru_gx_w': lru_gx_w, 'lru_gx_b': lru_gx_b, 'lru_lam': lru_lam, 'w_out': w_out, 'ln2_g': ln2_g,
            'w_up': w_up, 'ffn_conv_w': ffn_conv_w, 'ffn_conv_b': ffn_conv_b, 'w_down': w_down, 'lnf_g': lnf_g}


def reference(x_prompt, x_sample, state_rwkv, state_lru, c, c_ctx, ln1_g, w_mod, b_mod, w_in,
              rw_w0, rw_w_up, rw_a0, rw_a_up, rw_g_up, rw_k_k, rw_k_a, rw_r_k, rw_lnx_g, rw_lnx_b,
              lru_conv_w, lru_conv_b, lru_ga_w, lru_ga_b, lru_gx_w, lru_gx_b, lru_lam, w_out, ln2_g,
              w_up, ffn_conv_w, ffn_conv_b, w_down, lnf_g):
    bp = x_prompt.shape[0]
    yp = x_prompt
    ys = x_sample
    new_rwkv = []
    new_lru = []
    for l in range(DEPTH):
        lp = {'w_mod': w_mod[l], 'b_mod': b_mod[l], 'ln1_g': ln1_g[l], 'w_in': w_in[l],
              'rw_w0': rw_w0[l], 'rw_w_up': rw_w_up[l], 'rw_a0': rw_a0[l], 'rw_a_up': rw_a_up[l],
              'rw_g_up': rw_g_up[l], 'rw_k_k': rw_k_k[l], 'rw_k_a': rw_k_a[l], 'rw_r_k': rw_r_k[l],
              'rw_lnx_g': rw_lnx_g[l], 'rw_lnx_b': rw_lnx_b[l],
              'lru_conv_w': lru_conv_w[l], 'lru_conv_b': lru_conv_b[l], 'lru_ga_w': lru_ga_w[l],
              'lru_ga_b': lru_ga_b[l], 'lru_gx_w': lru_gx_w[l], 'lru_gx_b': lru_gx_b[l], 'lru_lam': lru_lam[l],
              'w_out': w_out[l], 'ln2_g': ln2_g[l], 'w_up': w_up[l], 'ffn_conv_w': ffn_conv_w[l],
              'ffn_conv_b': ffn_conv_b[l], 'w_down': w_down[l]}
        s0 = jnp.zeros((N_DIR, bp, HA, HEAD_A, HEAD_A), jnp.float32)
        h0 = jnp.zeros((N_DIR, bp, WB), jnp.float32)
        yp, s_fin, h_fin = block(yp, c_ctx, s0, h0, False, lp)
        new_rwkv.append(jnp.moveaxis(s_fin, 0, 1))
        new_lru.append(jnp.moveaxis(h_fin, 0, 1))
        ys, _, _ = block(ys, c, jnp.moveaxis(state_rwkv[:, l], 1, 0), jnp.moveaxis(state_lru[:, l], 1, 0), True, lp)
    y_prompt = rmsnorm(yp, lnf_g)
    y_sample = rmsnorm(ys, lnf_g)
    new_state_rwkv = jnp.stack(new_rwkv, axis=1).astype(x_prompt.dtype)
    new_state_lru = jnp.stack(new_lru, axis=1).astype(x_prompt.dtype)
    return (y_prompt, y_sample, new_state_rwkv, new_state_lru)
```

```cpp
#include <hip/hip_runtime.h>
#include <cstdio>
#include <cstdint>

namespace pg8 {
#define PG8_LAS __attribute__((address_space(3)))
typedef unsigned short bf16_t;
typedef short bf16x8 __attribute__((ext_vector_type(8)));
typedef float f32x4 __attribute__((ext_vector_type(4)));
typedef unsigned u32x4 __attribute__((ext_vector_type(4)));
constexpr int BM = 256, BK = 64, HALF = 128, HTB = HALF * BK * 2  , STAGE_BYTES = 8 * HTB, NXCD = 8, WGM = 8;

__host__ __device__ __forceinline__ int lds_byte(int r, int c) { const int st = (r >> 4) * 2 + (c >> 5), rr = r & 15, cc = c & 31, ob = rr * 64 + cc * 2; return st * 1024 + (ob ^ (((ob >> 9) & 1) << 5)); }
__host__ __device__ __forceinline__ void stage_rc(int b, int& R, int& C) { const int st = b / 1024, sb = b % 1024, swz = sb ^ (((sb >> 9) & 1) << 5); R = (st >> 1) * 16 + swz / 64; C = (st & 1) * 32 + (swz % 64) / 2; }
__host__ __device__ __forceinline__ int perm32(int rho) { const int n = rho >> 4, i = rho & 15; return 8 * (i >> 2) + 4 * n + (i & 3); }

struct Unit { int pm, pn; };
struct Gemm { const bf16_t* A; const bf16_t* Bt; int M, N, K; int lda; int apn; int apsh; };

struct StaticOrder {
    int nM, nN, nwg, G, c;
    __host__ __device__ void init(int M, int N, int G_, int c_) { nM = M / BM; nN = N / BM; nwg = nM * nN; G = G_; c = c_; }
    __host__ __device__ bool next(int i, Unit& u) const {
        const long L = (long)i * G + c; if (L >= nwg) return false;
        int wgid = (int)L; { const int q = nwg / NXCD, r = nwg % NXCD, xcd = wgid % NXCD, off = wgid / NXCD; wgid = (xcd < r ? xcd * (q + 1) : r * (q + 1) + (xcd - r) * q) + off; }
        const int nig = WGM * nN, gid = wgid / nig, fm = gid * WGM, gsz = (nM - fm) < WGM ? (nM - fm) : WGM;
        u.pm = fm + ((wgid % nig) % gsz); u.pn = (wgid % nig) / gsz; return true;
    }
    __device__ __forceinline__ void a_ready(const Unit&) const {}
    __device__ __forceinline__ void done(const Unit&) const {}
};

typedef __bf16 bf16x2_hw __attribute__((ext_vector_type(2)));
typedef float f32x2_cv __attribute__((ext_vector_type(2)));
__device__ __forceinline__ unsigned cvt_pk_bf16(float lo, float hi) { const f32x2_cv v = {lo, hi}; return __builtin_bit_cast(unsigned, __builtin_convertvector(v, bf16x2_hw)); }
typedef float f32x2 __attribute__((ext_vector_type(2)));
__device__ __forceinline__ f32x2 gelu_pk(f32x2 v) {
    const f32x2 av = __builtin_elementwise_abs(v), d = av * 0.2316418882f + 1.0f;
    f32x2 t; t.x = __builtin_amdgcn_rcpf(d.x); t.y = __builtin_amdgcn_rcpf(d.y);
    f32x2 q = t * 0.5307027145f + (-0.7265760135f); q = q * t + 0.7107068705f; q = q * t + (-0.142248368f); q = q * t + 0.127414796f; q = q * t;
    const f32x2 s = (v * v) * (-0.72134752044f);
    f32x2 e; e.x = __builtin_amdgcn_exp2f(s.x); e.y = __builtin_amdgcn_exp2f(s.y);
    const f32x2 m = v * (q * e), r = v - m;
    f32x2 o; o.x = v.x < 0.f ? m.x : r.x; o.y = v.y < 0.f ? m.y : r.y; return o;
}

template <int ACT  > struct EpiBf16 {
    static constexpr bool PERM = true, AFTER_DRAIN = false; static_assert(ACT == 0 || ACT == 1, "EpiBf16: ACT is 0 (none) or 1 (gelu_pk)");
    bf16_t* O; int ldc; const float* bias; int split_cols; size_t split_stride; float scale0;
    __device__ __forceinline__ void operator()(const f32x4 (&acc)[2][2][4][2], const Unit& u, int wr, int wc, int fr, int fq) const {
        const int row0 = u.pm * BM + wr * 64 + fr; int colt = u.pn * BM; bf16_t* base = O;
        float sc = 1.f; if (split_cols) { const int t = colt / split_cols; base += (size_t)t * split_stride; colt -= t * split_cols; if (t == 0) sc = scale0; }
        const int col0 = colt + wc * 32 + 8 * fq, bcol0 = u.pn * BM + wc * 32 + 8 * fq;
        f32x4 bv[2][2];
#pragma unroll
        for (int bj = 0; bj < 2; ++bj)
#pragma unroll
            for (int n = 0; n < 2; ++n) bv[bj][n] = bias ? *(const f32x4*)(bias + bcol0 + bj * HALF + 4 * n) : (f32x4){0.f, 0.f, 0.f, 0.f};
#pragma unroll
        for (int ai = 0; ai < 2; ++ai)
#pragma unroll
            for (int m = 0; m < 4; ++m) { bf16_t* rowp = base + (size_t)(row0 + ai * HALF + m * 16) * ldc + col0;
#pragma unroll
                for (int bj = 0; bj < 2; ++bj) { f32x4 v0 = acc[ai][bj][m][0] + bv[bj][0], v1 = acc[ai][bj][m][1] + bv[bj][1];
                    if (ACT == 1) { f32x2 a = gelu_pk((f32x2){v0[0], v0[1]}), b = gelu_pk((f32x2){v0[2], v0[3]}), c = gelu_pk((f32x2){v1[0], v1[1]}), d = gelu_pk((f32x2){v1[2], v1[3]});
                        v0 = (f32x4){a.x, a.y, b.x, b.y}; v1 = (f32x4){c.x, c.y, d.x, d.y}; }
                    v0 = v0 * sc; v1 = v1 * sc; u32x4 w; w.x = cvt_pk_bf16(v0[0], v0[1]); w.y = cvt_pk_bf16(v0[2], v0[3]); w.z = cvt_pk_bf16(v1[0], v1[1]); w.w = cvt_pk_bf16(v1[2], v1[3]);
                    *(u32x4*)(rowp + bj * HALF) = w; } }
    }
};

template <class Epi, class Sched, bool ALIGN_EPI = false, bool SP2 = false>
__device__ __forceinline__ void gemm_phase(PG8_LAS unsigned char* lds, const Gemm g, const Sched& S, const Epi& E) {
    int tid_ = threadIdx.x; asm volatile("" : "+v"(tid_));
    const int tid = tid_, wid = __builtin_amdgcn_readfirstlane(tid >> 6), lane = tid & 63, wr = wid >> 2, wc = wid & 3, fr = lane & 15, fq = lane >> 4;
    int K_ = g.K; asm volatile("" : "+s"(K_));
    const int K = K_, nt = K / BK;
    unsigned voffA[2], voffB[2];
#pragma unroll
    for (int i = 0; i < 2; ++i) { int R, C; stage_rc(tid * 16 + i * 8192, R, C); const int Rb = Epi::PERM ? ((R & ~31) + perm32(R & 31)) : R;
        voffA[i] = (unsigned)(R * g.lda + C) * 2u; voffB[i] = (unsigned)(Rb * K + C) * 2u; }
    const size_t kstep = (size_t)(BK * 2);
    const size_t hstepA = (size_t)HALF * g.lda * 2, hstepB = (size_t)HALF * K * 2;
    const size_t tstepA = 2 * hstepA, tstepB = 2 * hstepB, apnb = (size_t)g.apn * 2;
    const unsigned ldsw = (unsigned)wid * 1024u;
    const int aoff = lds_byte(wr * 64 + fr, fq * 8), boff = lds_byte(wc * 32 + fr, fq * 8);
#define PG8_SA(b, h) (((b) * 2 + (h)) * HTB)
#define PG8_SB(b, h) ((4 + (b) * 2 + (h)) * HTB)
#define PG8_STAGE(bufoff, gbase, voff) do { _Pragma("unroll") for (int _i = 0; _i < 2; ++_i) \
        __builtin_amdgcn_global_load_lds((const unsigned*)((const char*)(gbase) + (voff)[_i]), (PG8_LAS unsigned*)(lds + (bufoff) + ldsw + _i * 8192), 16, 0, 0); } while (0)
#define PG8_LDA(dst, b, h) do { _Pragma("unroll") for (int m = 0; m < 4; ++m) _Pragma("unroll") for (int k = 0; k < 2; ++k) dst[m][k] = *(const PG8_LAS bf16x8*)(lds + PG8_SA(b, h) + aoff + m * 2048 + k * 1024); } while (0)
#define PG8_LDB(dst, b, h) do { _Pragma("unroll") for (int n = 0; n < 2; ++n) _Pragma("unroll") for (int k = 0; k < 2; ++k) dst[n][k] = *(const PG8_LAS bf16x8*)(lds + PG8_SB(b, h) + boff + n * 2048 + k * 1024); } while (0)
#define PG8_MMA(ai, bj, At, Bt) do { __builtin_amdgcn_s_setprio(1); _Pragma("unroll") for (int m = 0; m < 4; ++m) _Pragma("unroll") for (int n = 0; n < 2; ++n) _Pragma("unroll") for (int k = 0; k < 2; ++k) \
        acc[ai][bj][m][n] = __builtin_amdgcn_mfma_f32_16x16x32_bf16(Bt[n][k], At[m][k], acc[ai][bj][m][n], 0, 0, 0); __builtin_amdgcn_s_setprio(0); } while (0)
#define PG8_WAIT_V(n) asm volatile("s_waitcnt vmcnt(" #n ")" ::: "memory")
#define PG8_WAIT_L(n) asm volatile("s_waitcnt lgkmcnt(" #n ")" ::: "memory")
#define PG8_BAR __builtin_amdgcn_s_barrier()
#define PG8_SCHED __builtin_amdgcn_sched_barrier(0)
    Unit cur, nxt; int ui = 0;
    if (!S.next(0, cur)) return;
    f32x4 acc[2][2][4][2];
#pragma unroll
    for (int a = 0; a < 2; ++a)
#pragma unroll
        for (int b = 0; b < 2; ++b)
#pragma unroll
            for (int m = 0; m < 4; ++m)
#pragma unroll
                for (int n = 0; n < 2; ++n) acc[a][b][m][n] = (f32x4){0.f, 0.f, 0.f, 0.f};
    bf16x8 At[4][2], B0[2][2], B1[2][2];
    const char* cA = (const char*)g.A + (size_t)cur.pm * tstepA + (size_t)(cur.pn >> g.apsh) * apnb; const char* cB = (const char*)g.Bt + (size_t)cur.pn * tstepB;
    S.a_ready(cur);
    if constexpr (SP2) {
        PG8_STAGE(PG8_SB(0, 0), cB, voffB); PG8_STAGE(PG8_SB(0, 1), cB + hstepB, voffB); PG8_STAGE(PG8_SA(0, 0), cA, voffA); PG8_STAGE(PG8_SA(0, 1), cA + hstepA, voffA);
        if (wr == 1) PG8_BAR;
        PG8_WAIT_V(2); PG8_BAR;
        PG8_STAGE(PG8_SB(1, 0), cB + kstep, voffB); PG8_STAGE(PG8_SA(1, 0), cA + kstep, voffA); PG8_STAGE(PG8_SB(1, 1), cB + hstepB + kstep, voffB);
        PG8_WAIT_V(6); PG8_BAR;
    } else {
        PG8_STAGE(PG8_SB(0, 0), cB, voffB); PG8_STAGE(PG8_SA(0, 0), cA, voffA); PG8_STAGE(PG8_SB(0, 1), cB + hstepB, voffB); PG8_STAGE(PG8_SA(0, 1), cA + hstepA, voffA);
        if (wr == 1) PG8_BAR;
        PG8_WAIT_V(4); PG8_BAR;
        PG8_STAGE(PG8_SB(1, 0), cB + kstep, voffB); PG8_STAGE(PG8_SA(1, 0), cA + kstep, voffA); PG8_STAGE(PG8_SB(1, 1), cB + hstepB + kstep, voffB);
        PG8_WAIT_V(6); PG8_BAR;
    }
    for (;;) {
        const bool has_next = S.next(ui + 1, nxt);
        const char* nA = has_next ? (const char*)g.A + (size_t)nxt.pm * tstepA + (size_t)(nxt.pn >> g.apsh) * apnb : cA; const char* nB = has_next ? (const char*)g.Bt + (size_t)nxt.pn * tstepB : cB;
        for (int t = 0; t < nt; t += 2) {
            const bool last = (t == nt - 2);
            const char* a1 = cA + (size_t)(t + 1) * kstep;
            const char* a2 = last ? nA : cA + (size_t)(t + 2) * kstep; const char* b2 = last ? nB : cB + (size_t)(t + 2) * kstep;
            const char* a3 = a2 + kstep; const char* b3 = b2 + kstep;
            if (last && has_next) S.a_ready(nxt);
            if constexpr (SP2) {
            PG8_LDB(B0, 0, 0); PG8_LDB(B1, 0, 1); PG8_SCHED; PG8_LDA(At, 0, 0); PG8_STAGE(PG8_SA(1, 1), a1 + hstepA, voffA);
            PG8_WAIT_V(8); PG8_WAIT_L(0); PG8_BAR; PG8_MMA(0, 0, At, B0); PG8_MMA(0, 1, At, B1); PG8_BAR; PG8_SCHED;
            PG8_LDA(At, 0, 1); PG8_STAGE(PG8_SB(0, 0), b2, voffB); PG8_STAGE(PG8_SB(0, 1), b2 + hstepB, voffB); PG8_STAGE(PG8_SA(0, 0), a2, voffA);
            PG8_WAIT_V(8); PG8_WAIT_L(0); PG8_BAR; PG8_MMA(1, 0, At, B0); PG8_MMA(1, 1, At, B1); PG8_BAR; PG8_SCHED;
            PG8_LDB(B0, 1, 0); PG8_LDB(B1, 1, 1); PG8_SCHED; PG8_LDA(At, 1, 0); PG8_STAGE(PG8_SA(0, 1), a2 + hstepA, voffA);
            PG8_WAIT_V(8); PG8_WAIT_L(0); PG8_BAR; PG8_MMA(0, 0, At, B0); PG8_MMA(0, 1, At, B1); PG8_BAR; PG8_SCHED;
            PG8_LDA(At, 1, 1); PG8_STAGE(PG8_SB(1, 0), b3, voffB); PG8_STAGE(PG8_SB(1, 1), b3 + hstepB, voffB); PG8_STAGE(PG8_SA(1, 0), a3, voffA);
            PG8_WAIT_V(8); PG8_WAIT_L(0); PG8_BAR; PG8_MMA(1, 0, At, B0); PG8_MMA(1, 1, At, B1); PG8_BAR; PG8_SCHED;
            } else {
            PG8_LDB(B0, 0, 0); PG8_SCHED; PG8_LDA(At, 0, 0); PG8_STAGE(PG8_SA(1, 1), a1 + hstepA, voffA);
            PG8_WAIT_L(8); PG8_BAR; PG8_WAIT_L(0); PG8_MMA(0, 0, At, B0); PG8_BAR; PG8_SCHED;
            PG8_LDB(B1, 0, 1); PG8_STAGE(PG8_SB(0, 0), b2, voffB);
            PG8_BAR; PG8_WAIT_L(0); PG8_MMA(0, 1, At, B1); PG8_BAR;
            PG8_LDA(At, 0, 1); PG8_STAGE(PG8_SA(0, 0), a2, voffA);
            PG8_BAR; PG8_WAIT_L(0); PG8_MMA(1, 0, At, B0); PG8_BAR; PG8_SCHED;
            PG8_STAGE(PG8_SB(0, 1), b2 + hstepB, voffB);
            PG8_WAIT_V(6); PG8_BAR; PG8_MMA(1, 1, At, B1); PG8_BAR;
            PG8_LDB(B0, 1, 0); PG8_SCHED; PG8_LDA(At, 1, 0); PG8_STAGE(PG8_SA(0, 1), a2 + hstepA, voffA);
            PG8_WAIT_L(8); PG8_BAR; PG8_WAIT_L(0); PG8_MMA(0, 0, At, B0); PG8_BAR; PG8_SCHED;
            PG8_LDB(B1, 1, 1); PG8_STAGE(PG8_SB(1, 0), b3, voffB);
            PG8_BAR; PG8_WAIT_L(0); PG8_MMA(0, 1, At, B1); PG8_BAR;
            PG8_LDA(At, 1, 1); PG8_STAGE(PG8_SA(1, 0), a3, voffA);
            PG8_BAR; PG8_WAIT_L(0); PG8_MMA(1, 0, At, B0); PG8_BAR; PG8_SCHED;
            PG8_STAGE(PG8_SB(1, 1), b3 + hstepB, voffB);
            PG8_WAIT_V(6); PG8_BAR; PG8_MMA(1, 1, At, B1); PG8_BAR;
            }
        }
        if constexpr (ALIGN_EPI) { if (wr == 0) PG8_BAR; }
        if constexpr (!Epi::AFTER_DRAIN) { E(acc, cur, wr, wc, fr, fq); S.done(cur); }
        if (!has_next) break;
#pragma unroll
        for (int a = 0; a < 2; ++a)
#pragma unroll
            for (int b = 0; b < 2; ++b)
#pragma unroll
                for (int m = 0; m < 4; ++m)
#pragma unroll
                    for (int n = 0; n < 2; ++n) acc[a][b][m][n] = (f32x4){0.f, 0.f, 0.f, 0.f};
        cur = nxt; cA = nA; cB = nB; ++ui;
        if constexpr (ALIGN_EPI) { if (wr == 1) PG8_BAR; }
    }
    PG8_WAIT_V(0);
    if constexpr (!ALIGN_EPI) { if (wr == 0) PG8_BAR; }
    PG8_BAR;
    if constexpr (Epi::AFTER_DRAIN) { E.fused(acc, cur, wr, wc, fr, fq, lds, wid, lane); S.done(cur); }
#undef PG8_SA
#undef PG8_SB
#undef PG8_STAGE
#undef PG8_LDA
#undef PG8_LDB
#undef PG8_MMA
#undef PG8_WAIT_V
#undef PG8_WAIT_L
#undef PG8_BAR
#undef PG8_SCHED
}
}

#ifndef MK_EN
#define MK_EN 0xFFFF
#endif
#ifndef MK_DBG_STOP
#define MK_DBG_STOP 0
#endif
#ifndef MK_DBG_BUF
#define MK_DBG_BUF 0
#endif
#ifndef MK_ONE_LAUNCH
#define MK_ONE_LAUNCH 0
#endif
#define GAS __attribute__((address_space(1)))
#define LAS __attribute__((address_space(3)))
typedef unsigned short bf16;
typedef unsigned v4u __attribute__((ext_vector_type(4)));
typedef unsigned v2u __attribute__((ext_vector_type(2)));
typedef float f32x4 __attribute__((ext_vector_type(4)));
typedef float f32x2 __attribute__((ext_vector_type(2)));
#define RLX_AGENT __ATOMIC_RELAXED, __HIP_MEMORY_SCOPE_AGENT
#define LDS_WAIT() asm volatile("s_waitcnt lgkmcnt(0)" ::: "memory")
#define VM_WAIT() asm volatile("s_waitcnt vmcnt(0)" ::: "memory")

constexpr int NWAVES = 8;
constexpr int D = 1024, M = 16384, NCTXROWS = 8192, DEPTH = 4, SEQ = 256, DSEQ = 2048, NB = 32, NDB = 4;
constexpr int PIN = 2816, DFF = 2816, NDEC = 2560, NAUX = 256, NLRU = 2048;
constexpr int C_R = 0, C_K = 512, C_V = 1024, C_XW = 1536, C_XB = 1792, C_GB = 2304;
constexpr float DECAY_SCALE = 0.6065306597126334f;
enum { I_XP = 0, I_XS, I_SRWKV, I_SLRU, I_C, I_CCTX, I_LN1G, I_WMOD, I_BMOD, I_WIN, I_RW_W0, I_RW_WUP, I_RW_A0, I_RW_AUP, I_RW_GUP, I_RW_KK, I_RW_KA, I_RW_RK,
       I_RW_LNXG, I_RW_LNXB, I_LRU_CW, I_LRU_CB, I_LRU_GAW, I_LRU_GAB, I_LRU_GXW, I_LRU_GXB, I_LRU_LAM, I_WOUT, I_LN2G, I_WUP, I_FCW, I_FCB, I_WDOWN, I_LNFG, N_IN };
constexpr size_t O_Y = 0, O_SRWKV = 16777216, O_SLRU = 16777216 + 8388608, OUT_TOTAL = 16777216 + 8388608 + 131072;
constexpr size_t MiB = 1u << 20;
constexpr size_t WS_CTL = 0, CTL_ZERO_BYTES = 1 * MiB;
constexpr size_t WS_MOD = 1 * MiB;
constexpr size_t WS_SPT = 1 * MiB + 512 * 1024;
constexpr size_t WS_MODP = 2 * MiB;
constexpr size_t WS_W = 8 * MiB;
constexpr size_t WL_STRIDE = 26 * MiB + MiB / 4, WL_IN = 0, WL_OUT = 5 * MiB + MiB / 2, WL_UP = WL_OUT + 2 * MiB, WL_DOWN = WL_UP + 11 * MiB, WL_AUX = WL_DOWN + 5 * MiB + MiB / 2, WL_LRU = WL_AUX + MiB + MiB / 4;
static_assert(WL_LRU + 1 * MiB == WL_STRIDE, "weight map");
constexpr size_t WS_XN = WS_W + 4 * WL_STRIDE;
constexpr size_t WS_PROJ = WS_XN + 32 * MiB;
constexpr size_t WS_DEC = WS_PROJ + 88 * MiB;
constexpr size_t WS_LRU = WS_DEC + 80 * MiB;
constexpr size_t WS_END = WS_LRU + 64 * MiB;
static_assert(WS_END == 377 * MiB, "ws map");
constexpr int CW_BAR = 4096;

__device__ __forceinline__ unsigned f2bf(float f) { unsigned u = __builtin_bit_cast(unsigned, f); return (u + 0x7fffu + ((u >> 16) & 1u)) >> 16; }
__device__ __forceinline__ unsigned pk2(float lo, float hi) { return pg8::cvt_pk_bf16(lo, hi); }
__device__ __forceinline__ float bflo(unsigned w) { return __builtin_bit_cast(float, w << 16); }
__device__ __forceinline__ float bfhi(unsigned w) { return __builtin_bit_cast(float, w & 0xffff0000u); }
__device__ __forceinline__ float bf2f(bf16 h) { return __builtin_bit_cast(float, (unsigned)h << 16); }
__device__ __forceinline__ float fsigmoid(float x) { return __builtin_amdgcn_rcpf(1.0f + __builtin_amdgcn_exp2f(-1.4426950409f * x)); }
__device__ __forceinline__ float ftanh(float x) { return 2.0f * fsigmoid(2.0f * x) - 1.0f; }
__device__ __forceinline__ float gelu_tanh(float x) { const float z = 0.7978845608f * (x + 0.044715f * x * x * x); return x * fsigmoid(2.0f * z); }
__device__ __forceinline__ float fexp(float x) { return __builtin_amdgcn_exp2f(1.4426950409f * x); }
__device__ __forceinline__ float wave_sum(float v) {
#pragma unroll
    for (int o = 1; o < 64; o <<= 1) v += __shfl_xor(v, o);
    return v;
}

#define XB_TMO      128
#define XB_XCNT(j)  (256  + 64 * (j))
#define XB_XSUB(j)  (1280 + 64 * (j))
#define XB_XGEN(j)  (2304 + 64 * (j))
#define XB_TOP      3328
#define XB_TOPGEN   3392
#define XCD_BAR_WORDS 3456
#define XB_SPIN_CAP (1u << 20)
__device__ __forceinline__ unsigned xb_ld(unsigned* p)              { return __hip_atomic_load(p, __ATOMIC_RELAXED, __HIP_MEMORY_SCOPE_AGENT); }
__device__ __forceinline__ unsigned xb_add(unsigned* p, unsigned v) { return __hip_atomic_fetch_add(p, v, __ATOMIC_RELAXED, __HIP_MEMORY_SCOPE_AGENT); }
__device__ __forceinline__ unsigned xb_xcc_id() { return (unsigned)__builtin_amdgcn_s_getreg((3 << 11) | 20) & 0xFu; }
#define XB_SPIN(cond, bar) do { unsigned _sp = 0; while (cond) { __builtin_amdgcn_s_sleep(1); \
    if ((++_sp & 255u) == 0u) { if (xb_ld(&(bar)[XB_TMO])) break; if (_sp > XB_SPIN_CAP) { atomicAdd(&(bar)[XB_TMO], 1u); break; } } } } while (0)
struct XcdBarrier { unsigned* bar; unsigned x; volatile LAS unsigned* st; };
__device__ __forceinline__ XcdBarrier xcd_barrier_post(unsigned* bar, volatile LAS unsigned* st) {
    XcdBarrier b; b.bar = bar; b.x = xb_xcc_id(); b.st = st;
    if (threadIdx.x == 0) (void)xb_add(&bar[XB_XCNT(b.x)], 1u);
    return b;
}
__device__ __forceinline__ void xcd_barrier_complete(unsigned* bar, unsigned x, unsigned& nloc, unsigned& nx) {
    const unsigned G = gridDim.x * gridDim.y * gridDim.z;
    unsigned sum, cnt, mine, sp = 0u;
    for (;;) {
        sum = 0u; cnt = 0u; mine = 0u;
#pragma unroll
        for (unsigned j = 0; j < 16; ++j) { const unsigned c = xb_ld(&bar[XB_XCNT(j)]); sum += c; cnt += (c > 0u) ? 1u : 0u; mine = (j == x) ? c : mine; }
        if (sum == G) break;
        __builtin_amdgcn_s_sleep(1);
        if ((++sp & 255u) == 0u) { if (xb_ld(&bar[XB_TMO])) break; if (sp > XB_SPIN_CAP) { atomicAdd(&bar[XB_TMO], 1u); break; } }
    }
    nloc = mine > 0u ? mine : 1u; nx = cnt > 0u ? cnt : 1u;
}
__device__ __forceinline__ void xcd_barrier(const XcdBarrier& b) {
    asm volatile("s_waitcnt vmcnt(0)" ::: "memory");
    __syncthreads();
    if (threadIdx.x == 0) {
        unsigned* bar = b.bar;
        __builtin_amdgcn_s_waitcnt(0);
        unsigned nloc = b.st[0], nx = b.st[1];
        if (nloc == 0u) { xcd_barrier_complete(bar, b.x, nloc, nx); b.st[0] = nloc; b.st[1] = nx; }
        const unsigned old = xb_add(&bar[XB_XSUB(b.x)], 1u);
        const unsigned gen = old / nloc;
        if (old + 1u == (gen + 1u) * nloc) {
            __builtin_amdgcn_fence(__ATOMIC_RELEASE, "agent");
            asm volatile("s_waitcnt vmcnt(0)" ::: "memory");
            const unsigned og = xb_add(&bar[XB_TOP], 1u);
            const unsigned tg = og / nx;
            if (og + 1u == (tg + 1u) * nx) xb_add(&bar[XB_TOPGEN], 1u);
            else XB_SPIN(xb_ld(&bar[XB_TOPGEN]) == tg, bar);
            __builtin_amdgcn_fence(__ATOMIC_ACQUIRE, "agent");
            xb_add(&bar[XB_XGEN(b.x)], 1u);
            asm volatile("s_waitcnt vmcnt(0)" ::: "memory");
        } else {
            XB_SPIN(xb_ld(&bar[XB_XGEN(b.x)]) == gen, bar);
            __builtin_amdgcn_fence(__ATOMIC_ACQUIRE, "agent");
            asm volatile("s_waitcnt vmcnt(0)" ::: "memory");
        }
    }
    __syncthreads();
}

constexpr int RING_OFF = 0, RING_BYTES = 131072;
constexpr int XBUF_OFF = RING_BYTES;
constexpr int LDSCTL_OFF = RING_BYTES + 8192, MISC_OFF = LDSCTL_OFF + 320;
constexpr int LDS_BYTES = 147456;
static_assert(MISC_OFF + 128 <= LDS_BYTES, "LDS map");

struct Args { const float* in[N_IN]; float* out; unsigned char* ws; int ph_lo, ph_hi; };
static_assert(sizeof(Args) == N_IN * 8 + 24, "Args has no padding");

struct Frame {
    LAS unsigned char* lds;
    int tid, lane, wave, vcu, G;
    const float* const* in;
    float* out; unsigned char* ws;
};
__device__ __forceinline__ bf16* wlayer(const Frame& F, int l, size_t off) { return (bf16*)(F.ws + WS_W + (size_t)l * WL_STRIDE + off); }
__device__ __forceinline__ const float* modp(const Frame& F, int l, int bi) { return (const float*)(F.ws + WS_MOD) + ((size_t)l * 5 + bi) * 6144; }
__device__ __forceinline__ int row_bidx(int r) { return r < NCTXROWS ? 0 : 1 + ((r - NCTXROWS) >> 11); }

namespace pg8 {
struct EpiProj {
    static constexpr bool PERM = true, AFTER_DRAIN = false;
    bf16_t* O; bf16_t* AUX;
    __device__ __forceinline__ void operator()(const f32x4 (&acc)[2][2][4][2], const Unit& u, int wr, int wc, int fr, int fq) const {
        const int row0 = u.pm * BM + wr * 64 + fr; const int ct0 = wc * 32 + 8 * fq; const int col0 = u.pn * BM + ct0;
#pragma unroll
        for (int ai = 0; ai < 2; ++ai)
#pragma unroll
            for (int m = 0; m < 4; ++m) { const size_t row = (size_t)(row0 + ai * HALF + m * 16); bf16_t* rowp = O + row * PIN + col0;
#pragma unroll
                for (int bj = 0; bj < 2; ++bj) { const f32x4 v0 = acc[ai][bj][m][0], v1 = acc[ai][bj][m][1];
                    u32x4 w; w.x = cvt_pk_bf16(v0[0], v0[1]); w.y = cvt_pk_bf16(v0[2], v0[3]); w.z = cvt_pk_bf16(v1[0], v1[1]); w.w = cvt_pk_bf16(v1[2], v1[3]);
                    *(u32x4*)(rowp + bj * HALF) = w;
                    if (u.pn == 6) { float t[8] = {v0[0], v0[1], v0[2], v0[3], v1[0], v1[1], v1[2], v1[3]};
                        if (bj == 1) {
#pragma unroll
                            for (int e = 0; e < 8; ++e) t[e] = fsigmoid(t[e]); }
                        else if (wc < 2) {
#pragma unroll
                            for (int e = 0; e < 8; ++e) t[e] = ftanh(t[e]); }
                        u32x4 a; a.x = cvt_pk_bf16(t[0], t[1]); a.y = cvt_pk_bf16(t[2], t[3]); a.z = cvt_pk_bf16(t[4], t[5]); a.w = cvt_pk_bf16(t[6], t[7]);
                        *(u32x4*)(AUX + row * NAUX + ct0 + bj * HALF) = a; } } }
    }
};
struct EpiDec {
    static constexpr bool PERM = true, AFTER_DRAIN = false;
    bf16_t* O; const float* w0; const float* a0;
    __device__ __forceinline__ void operator()(const f32x4 (&acc)[2][2][4][2], const Unit& u, int wr, int wc, int fr, int fq) const {
        const int row0 = u.pm * BM + wr * 64 + fr; const int ct0 = wc * 32 + 8 * fq; const int col0 = u.pn * BM + ct0;
        const int kind = u.pn < 4 ? 0 : (u.pn < 8 ? 1 : 2);
        const float* bp = kind == 0 ? w0 + u.pn * 256 : a0 + (u.pn - 4) * 256;
#pragma unroll
        for (int bj = 0; bj < 2; ++bj) {
            const f32x4 b0 = kind < 2 ? *(const f32x4*)(bp + ct0 + bj * HALF) : (f32x4){0.f, 0.f, 0.f, 0.f}, b1 = kind < 2 ? *(const f32x4*)(bp + ct0 + bj * HALF + 4) : (f32x4){0.f, 0.f, 0.f, 0.f};
            const float s = kind == 0 ? -DECAY_SCALE : 1.0f;
#pragma unroll
            for (int ai = 0; ai < 2; ++ai)
#pragma unroll
                for (int m = 0; m < 4; ++m) { bf16_t* rowp = O + (size_t)(row0 + ai * HALF + m * 16) * NDEC + col0;
                    f32x4 v0 = acc[ai][bj][m][0] + b0, v1 = acc[ai][bj][m][1] + b1;
                    if (kind < 2) {
#pragma unroll
                        for (int e = 0; e < 4; ++e) { v0[e] = s * fsigmoid(v0[e]); v1[e] = s * fsigmoid(v1[e]); } }
                    u32x4 w; w.x = cvt_pk_bf16(v0[0], v0[1]); w.y = cvt_pk_bf16(v0[2], v0[3]); w.z = cvt_pk_bf16(v1[0], v1[1]); w.w = cvt_pk_bf16(v1[2], v1[3]);
                    *(u32x4*)(rowp + bj * HALF) = w; }
        }
    }
};
struct EpiLru {
    static constexpr bool PERM = false, AFTER_DRAIN = false;
    bf16_t* LRU; const bf16_t* XC; const float* gab; const float* gxb; const float* spt;
    __device__ __forceinline__ void operator()(const f32x4 (&acc)[2][2][4][2], const Unit& u, int wr, int wc, int fr, int fq) const {
        const int row0 = u.pm * BM + wr * 64 + fr; const int c0 = u.pn * 64 + wc * 16 + fq * 4;
#pragma unroll
        for (int d = 0; d < 2; ++d) {
            const f32x4 bga = *(const f32x4*)(gab + d * 512 + c0), bgx = *(const f32x4*)(gxb + d * 512 + c0), sp = *(const f32x4*)(spt + d * 512 + c0);
#pragma unroll
            for (int ai = 0; ai < 2; ++ai)
#pragma unroll
                for (int m = 0; m < 4; ++m) { const size_t row = (size_t)(row0 + ai * HALF + m * 16);
                    const v2u xw = *(const v2u*)(XC + row * 512 + c0); const float xc[4] = {bflo(xw.x), bfhi(xw.x), bflo(xw.y), bfhi(xw.y)};
                    float la[4], uu[4];
#pragma unroll
                    for (int e = 0; e < 4; ++e) { const float rg = fsigmoid(acc[ai][0][m][d][e] + bga[e]), ig = fsigmoid(acc[ai][1][m][d][e] + bgx[e]);
                        la[e] = sp[e] * rg; const float x2 = 2.0f * la[e];
                        const float em1 = x2 > -0.25f ? -x2 * (1.0f + x2 * (0.5f + x2 * (0.16666667f + x2 * (0.041666668f + x2 * (0.0083333338f + x2 * 0.0013888889f))))) : 1.0f - fexp(x2);
                        uu[e] = sqrtf(em1) * (ig * xc[e]); }
                    bf16_t* p = LRU + (row * 2 + d) * 1024 + c0;
                    v2u w1; w1.x = cvt_pk_bf16(la[0], la[1]); w1.y = cvt_pk_bf16(la[2], la[3]); *(v2u*)p = w1;
                    v2u w2; w2.x = cvt_pk_bf16(uu[0], uu[1]); w2.y = cvt_pk_bf16(uu[2], uu[3]); *(v2u*)(p + 512) = w2; }
        }
    }
};
struct EpiRes {
    static constexpr bool PERM = false, AFTER_DRAIN = false;
    const float* baseA; const float* baseB; float* out; const float* gate0;
    __device__ __forceinline__ void operator()(const f32x4 (&acc)[2][2][4][2], const Unit& u, int wr, int wc, int fr, int fq) const {
        const int row0 = u.pm * BM + wr * 64 + fr, col0 = u.pn * BM + wc * 32 + 4 * fq;
        const int bi = u.pm < 32 ? 0 : 1 + ((u.pm - 32) >> 3);
        const float* gp = gate0 + (size_t)bi * 6144 + col0;
        const float* bs = u.pm < 32 ? baseA : baseB - (size_t)NCTXROWS * D;
        f32x4 gv[2][2];
#pragma unroll
        for (int bj = 0; bj < 2; ++bj)
#pragma unroll
            for (int n = 0; n < 2; ++n) gv[bj][n] = *(const f32x4*)(gp + bj * HALF + n * 16);
#pragma unroll
        for (int ai = 0; ai < 2; ++ai)
#pragma unroll
            for (int m = 0; m < 4; ++m) { const size_t off = (size_t)(row0 + ai * HALF + m * 16) * D + col0;
#pragma unroll
                for (int bj = 0; bj < 2; ++bj)
#pragma unroll
                    for (int n = 0; n < 2; ++n) { const f32x4 b = *(const f32x4*)(bs + off + bj * HALF + n * 16); *(f32x4*)(out + off + bj * HALF + n * 16) = b + gv[bj][n] * acc[ai][bj][m][n]; } }
    }
};
template <int CTRL, bool BC> __device__ __forceinline__ float dpp_f(float oldv, float x) {
    return __builtin_bit_cast(float, __builtin_amdgcn_update_dpp(__builtin_bit_cast(int, oldv), __builtin_bit_cast(int, x), CTRL, 0xf, 0xf, BC));
}
struct EpiFfn {
    static constexpr bool PERM = true, AFTER_DRAIN = false;
    bf16_t* ACT; const float* cw; const float* cb; PG8_LAS float* xbuf;
    __device__ __forceinline__ void operator()(const f32x4 (&acc)[2][2][4][2], const Unit& u, int wr, int wc, int fr, int fq) const {
        const bool ctx = u.pm < 32;
        const int wid = wr * 4 + wc;
        if (ctx) {
#pragma unroll
            for (int ai = 0; ai < 2; ++ai)
#pragma unroll
                for (int bj = 0; bj < 2; ++bj)
#pragma unroll
                    for (int n = 0; n < 2; ++n) {
                        if (fr == 0)  *(PG8_LAS f32x4*)(xbuf + ((((wid * 2 + ai) * 2 + 0) * 4 + fq) * 4 + bj * 2 + n) * 4) = acc[ai][bj][0][n];
                        if (fr == 15) *(PG8_LAS f32x4*)(xbuf + ((((wid * 2 + ai) * 2 + 1) * 4 + fq) * 4 + bj * 2 + n) * 4) = acc[ai][bj][3][n];
                    }
            asm volatile("s_waitcnt lgkmcnt(0)" ::: "memory"); __builtin_amdgcn_s_barrier(); asm volatile("" ::: "memory");
        }
        const int row0 = u.pm * BM + wr * 64 + fr; const int ct0 = wc * 32 + 8 * fq;
#pragma unroll
        for (int n = 0; n < 2; ++n) {
            const int ca = u.pn * 128 + ct0 + 4 * n;
            f32x4 w0a = *(const f32x4*)(cw + ca), w1a = *(const f32x4*)(cw + 5632 + ca), w2a = *(const f32x4*)(cw + 2 * 5632 + ca), cba = *(const f32x4*)(cb + ca);
            f32x4 w0b = *(const f32x4*)(cw + 2816 + ca), w1b = *(const f32x4*)(cw + 5632 + 2816 + ca), w2b = *(const f32x4*)(cw + 2 * 5632 + 2816 + ca), cbb = *(const f32x4*)(cb + 2816 + ca);
#pragma unroll
            for (int ai = 0; ai < 2; ++ai) {
                const int blk = 2 * ai + wr;
                f32x4 pa = {0.f, 0.f, 0.f, 0.f}, pb = pa, na = pa, nb = pa;
                if (ctx && blk > 0) { const int pw = ((blk - 1) & 1) * 4 + wc, pai = (blk - 1) >> 1;
                    pa = *(const PG8_LAS f32x4*)(xbuf + ((((pw * 2 + pai) * 2 + 1) * 4 + fq) * 4 + 0 * 2 + n) * 4); pb = *(const PG8_LAS f32x4*)(xbuf + ((((pw * 2 + pai) * 2 + 1) * 4 + fq) * 4 + 1 * 2 + n) * 4); }
                if (ctx && blk < 3) { const int nw = ((blk + 1) & 1) * 4 + wc, nai = (blk + 1) >> 1;
                    na = *(const PG8_LAS f32x4*)(xbuf + ((((nw * 2 + nai) * 2 + 0) * 4 + fq) * 4 + 0 * 2 + n) * 4); nb = *(const PG8_LAS f32x4*)(xbuf + ((((nw * 2 + nai) * 2 + 0) * 4 + fq) * 4 + 1 * 2 + n) * 4); }
#pragma unroll
                for (int m = 0; m < 4; ++m) {
                    float o[4];
#pragma unroll
                    for (int e = 0; e < 4; ++e) {
                        const float xa = acc[ai][0][m][n][e], xb = acc[ai][1][m][n][e];
                        const float ta = m > 0 ? dpp_f<0x10F, true>(0.f, acc[ai][0][m > 0 ? m - 1 : 0][n][e]) : pa[e];
                        const float tb = m > 0 ? dpp_f<0x10F, true>(0.f, acc[ai][1][m > 0 ? m - 1 : 0][n][e]) : pb[e];
                        const float ba = m < 3 ? dpp_f<0x11F, true>(0.f, acc[ai][0][m < 3 ? m + 1 : 3][n][e]) : na[e];
                        const float bb = m < 3 ? dpp_f<0x11F, true>(0.f, acc[ai][1][m < 3 ? m + 1 : 3][n][e]) : nb[e];
                        const float upa = dpp_f<0x111, false>(ta, xa), upb = dpp_f<0x111, false>(tb, xb);
                        const float dna = dpp_f<0x101, false>(ba, xa), dnb = dpp_f<0x101, false>(bb, xb);
                        const float ua = cba[e] + w0a[e] * upa + w1a[e] * xa + w2a[e] * dna;
                        const float ub = cbb[e] + w0b[e] * upb + w1b[e] * xb + w2b[e] * dnb;
                        o[e] = gelu_tanh(ua) * ub;
                    }
                    v2u w; w.x = cvt_pk_bf16(o[0], o[1]); w.y = cvt_pk_bf16(o[2], o[3]);
                    *(v2u*)(ACT + (size_t)(row0 + ai * HALF + m * 16) * DFF + ca) = w;
                }
            }
        }
    }
};
}

template <class RowMap>
__device__ __forceinline__ void transpose_item(const float* W, int srcN, int k0, int n0, bf16* dst, int dstK, int kdst0, RowMap rm, LAS float* scr, int lane) {
#pragma unroll 8
    for (int i = 0; i < 32; ++i) { const int kk = 2 * i + (lane >> 5); scr[kk * 33 + (lane & 31)] = W[(size_t)(k0 + kk) * srcN + n0 + (lane & 31)]; }
    LDS_WAIT(); asm volatile("" ::: "memory");
    const int c = lane & 7;
#pragma unroll
    for (int j = 0; j < 4; ++j) { const int n = (lane >> 3) + 8 * j; const LAS float* s = scr + (8 * c) * 33 + n;
        v4u o; o.x = pk2(s[0 * 33], s[1 * 33]); o.y = pk2(s[2 * 33], s[3 * 33]); o.z = pk2(s[4 * 33], s[5 * 33]); o.w = pk2(s[6 * 33], s[7 * 33]);
        *(GAS v4u*)(dst + (size_t)rm(n) * dstK + kdst0 + 8 * c) = o; }
    LDS_WAIT(); asm volatile("" ::: "memory");
}
constexpr int IT_IN = 16 * 88, IT_OUT = 16 * 32, IT_UP = 16 * 176, IT_DOWN = 44 * 32, IT_AUX = 96, IT_LRU = 64, IT_LAYER = IT_IN + IT_OUT + IT_UP + IT_DOWN + IT_AUX + IT_LRU;
constexpr int ZR_LAYER = NDEC + NLRU;
constexpr int N_T0 = DEPTH * IT_LAYER, N_T1 = DEPTH * ZR_LAYER, N_T2 = DEPTH * 8 * 24;
__device__ __forceinline__ void p0_prologue(Frame& F) {
    LAS float* scr = (LAS float*)(F.lds + RING_OFF + F.wave * 16384);
    const int gw = F.vcu * NWAVES + F.wave, NGW = F.G * NWAVES; const int lane = F.lane;
    for (int t = gw; t < N_T2; t += NGW) {
        const int l = t / 192, ks = (t % 192) / 24, nb = t % 24;
        const float* W = F.in[I_WMOD] + ((size_t)l * 1024 + ks * 128) * 6144 + nb * 256 + lane * 4;
        f32x4 a0 = {0.f, 0.f, 0.f, 0.f}, a1 = a0, a2 = a0, a3 = a0, a4 = a0;
#pragma unroll 4
        for (int k = 0; k < 128; ++k) {
            const f32x4 w = *(const f32x4*)(W + (size_t)k * 6144); const int kk = ks * 128 + k;
            const float c0 = F.in[I_CCTX][kk], c1 = F.in[I_C][kk], c2 = F.in[I_C][1024 + kk], c3 = F.in[I_C][2048 + kk], c4 = F.in[I_C][3072 + kk];
            a0 += (c0 * fsigmoid(c0)) * w; a1 += (c1 * fsigmoid(c1)) * w; a2 += (c2 * fsigmoid(c2)) * w; a3 += (c3 * fsigmoid(c3)) * w; a4 += (c4 * fsigmoid(c4)) * w;
        }
        float* P = (float*)(F.ws + WS_MODP) + (((size_t)l * 8 + ks) * 5) * 6144 + nb * 256 + lane * 4;
        *(f32x4*)(P) = a0; *(f32x4*)(P + 6144) = a1; *(f32x4*)(P + 2 * 6144) = a2; *(f32x4*)(P + 3 * 6144) = a3; *(f32x4*)(P + 4 * 6144) = a4;
    }
    for (int it = gw; it < N_T0; it += NGW) {
        const int l = it / IT_LAYER; int r = it % IT_LAYER;
        if (r < IT_IN) { const int kb = r / 88, nb = r % 88; transpose_item(F.in[I_WIN] + (size_t)l * 1024 * PIN, PIN, 64 * kb, 32 * nb, wlayer(F, l, WL_IN), 1024, 64 * kb, [=](int n) { return 32 * nb + n; }, scr, lane); continue; } r -= IT_IN;
        if (r < IT_OUT) { const int kb = r / 32, nb = r % 32; transpose_item(F.in[I_WOUT] + (size_t)l * 1024 * 1024, 1024, 64 * kb, 32 * nb, wlayer(F, l, WL_OUT), 1024, 64 * kb, [=](int n) { return 32 * nb + n; }, scr, lane); continue; } r -= IT_OUT;
        if (r < IT_UP) { const int kb = r / 176, nb = r % 176; const int n0 = 32 * nb; const int nn = n0 < DFF ? n0 : n0 - DFF; const int rb = 256 * (nn / 128) + (n0 < DFF ? 0 : 128) + (nn % 128);
            transpose_item(F.in[I_WUP] + (size_t)l * 1024 * 5632, 5632, 64 * kb, n0, wlayer(F, l, WL_UP), 1024, 64 * kb, [=](int n) { return rb + n; }, scr, lane); continue; } r -= IT_UP;
        if (r < IT_DOWN) { const int kb = r / 32, nb = r % 32; transpose_item(F.in[I_WDOWN] + (size_t)l * DFF * 1024, 1024, 64 * kb, 32 * nb, wlayer(F, l, WL_DOWN), DFF, 64 * kb, [=](int n) { return 32 * nb + n; }, scr, lane); continue; } r -= IT_DOWN;
        if (r < IT_AUX) {
            if (r < 32) { const int d = r / 16, nb = r % 16; transpose_item(F.in[I_RW_WUP] + ((size_t)l * 2 + d) * 64 * 512, 512, 0, 32 * nb, wlayer(F, l, WL_AUX), NAUX, 0, [=](int n) { return d * 512 + 32 * nb + n; }, scr, lane); }
            else if (r < 64) { const int d = (r - 32) / 16, nb = r % 16; transpose_item(F.in[I_RW_AUP] + ((size_t)l * 2 + d) * 64 * 512, 512, 0, 32 * nb, wlayer(F, l, WL_AUX), NAUX, 64, [=](int n) { return 1024 + d * 512 + 32 * nb + n; }, scr, lane); }
            else { const int kb = (r - 64) / 16, nb = r % 16; transpose_item(F.in[I_RW_GUP] + (size_t)l * 128 * 512, 512, 64 * kb, 32 * nb, wlayer(F, l, WL_AUX), NAUX, 128 + 64 * kb, [=](int n) { return 2048 + 32 * nb + n; }, scr, lane); }
            continue; } r -= IT_AUX;
        { const int q = r / 16, h = (r % 16) / 2, nb = r % 2;
          const float* src = (q < 2 ? F.in[I_LRU_GAW] : F.in[I_LRU_GXW]) + (((size_t)l * 2 + (q & 1)) * 8 + h) * 4096;
          transpose_item(src, 64, 0, 32 * nb, wlayer(F, l, WL_LRU), 256, 64 * (h & 3), [=](int n) { const int j = 32 * nb + n; return 256 * h + 128 * (q >> 1) + 16 * (q & 1) + 32 * (j >> 4) + (j & 15); }, scr, lane); }
    }
    for (int t = gw; t < N_T1; t += NGW) {
        const int l = t / ZR_LAYER, r = t % ZR_LAYER; const int k = 4 * lane;
        if (r < NDEC) { const int lo = r < 1024 ? 0 : (r < 2048 ? 64 : 128), hi = r < 1024 ? 64 : (r < 2048 ? 128 : 256);
            if (k < lo || k >= hi) *(GAS v2u*)(wlayer(F, l, WL_AUX) + (size_t)r * NAUX + k) = (v2u){0u, 0u}; }
        else { const int rr = r - NDEC, h = rr >> 8; const int lo = 64 * (h & 3);
            if (k < lo || k >= lo + 64) *(GAS v2u*)(wlayer(F, l, WL_LRU) + (size_t)rr * 256 + k) = (v2u){0u, 0u}; }
    }
}
__device__ __forceinline__ void p1_modreduce(Frame& F) {
    const int gt = (F.vcu * NWAVES + F.wave) * 64 + F.lane, NT = F.G * NWAVES * 64;
    for (int i = gt; i < DEPTH * 5 * 6144; i += NT) { const int l = i / (5 * 6144), r = i % (5 * 6144), n = r % 6144, bi = r / 6144;
        float s = F.in[I_BMOD][l * 6144 + n];
#pragma unroll
        for (int ks = 0; ks < 8; ++ks) s += ((const float*)(F.ws + WS_MODP))[(((size_t)l * 8 + ks) * 5 + bi) * 6144 + n];
        ((float*)(F.ws + WS_MOD))[i] = s; }
    for (int i = gt; i < DEPTH * 1024; i += NT) { const float x = -F.in[I_LRU_LAM][i]; ((float*)(F.ws + WS_SPT))[i] = -8.0f * (fmaxf(x, 0.f) + log1pf(expf(-fabsf(x)))); }
}
__device__ __forceinline__ void modnorm_row(const float* xrow, bf16* orow, const float* g, const float* sc, const float* sh, int lane) {
    const GAS f32x4* xr = (const GAS f32x4*)xrow + lane;
    f32x4 v[4]; float s = 0.f;
#pragma unroll
    for (int j = 0; j < 4; ++j) { v[j] = xr[64 * j]; s += (v[j].x * v[j].x + v[j].y * v[j].y) + (v[j].z * v[j].z + v[j].w * v[j].w); }
    const float rstd = 1.0f / sqrtf(wave_sum(s) * (1.f / D) + 1e-6f);
    GAS unsigned long long* o8 = (GAS unsigned long long*)orow + lane;
#pragma unroll
    for (int j = 0; j < 4; ++j) { const int c = 4 * lane + 256 * j; const f32x4 gg = *(const f32x4*)(g + c), ss = *(const f32x4*)(sc + c), hh = *(const f32x4*)(sh + c);
        const f32x4 y = v[j] * rstd * gg * (ss + 1.0f) + hh;
        o8[64 * j] = (unsigned long long)pk2(y.x, y.y) | ((unsigned long long)pk2(y.z, y.w) << 32); }
}
__device__ __forceinline__ const float* xrow_in(const Frame& F, int r) { return r < NCTXROWS ? F.in[I_XP] + (size_t)r * D : F.in[I_XS] + (size_t)(r - NCTXROWS) * D; }
__device__ __forceinline__ void p_modnorm(Frame& F, int l, int which, bool from_input) {
    const int gw = F.vcu * NWAVES + F.wave, NGW = F.G * NWAVES;
    const float* g = F.in[which ? I_LN2G : I_LN1G] + l * D;
    for (int r = gw; r < M; r += NGW) { const float* mp = modp(F, l, row_bidx(r)) + (which ? 3072 : 0);
        modnorm_row(from_input ? xrow_in(F, r) : F.out + (size_t)r * D, (bf16*)(F.ws + WS_XN) + (size_t)r * D, g, mp + 1024, mp, F.lane); }
}
__device__ __forceinline__ void p_finalnorm(Frame& F) {
    const int gw = F.vcu * NWAVES + F.wave, NGW = F.G * NWAVES; const float* g = F.in[I_LNFG];
    for (int r = gw; r < M; r += NGW) { GAS f32x4* xr = (GAS f32x4*)(F.out + (size_t)r * D) + F.lane;
        f32x4 v[4]; float s = 0.f;
#pragma unroll
        for (int j = 0; j < 4; ++j) { v[j] = xr[64 * j]; s += (v[j].x * v[j].x + v[j].y * v[j].y) + (v[j].z * v[j].z + v[j].w * v[j].w); }
        const float rstd = 1.0f / sqrtf(wave_sum(s) * (1.f / D) + 1e-6f);
#pragma unroll
        for (int j = 0; j < 4; ++j) { const f32x4 gg = *(const f32x4*)(g + 4 * F.lane + 256 * j); xr[64 * j] = v[j] * rstd * gg; } }
}
__device__ __forceinline__ void p_lruconv(Frame& F, int l) {
    const int gt = (F.vcu * NWAVES + F.wave) * 64 + F.lane, NT = F.G * NWAVES * 64;
    const bf16* PROJ = (const bf16*)(F.ws + WS_PROJ); bf16* XC = (bf16*)(F.ws + WS_XN);
    const float* cw = F.in[I_LRU_CW] + l * 4 * 512; const float* cb = F.in[I_LRU_CB] + l * 512;
    for (int i = gt; i < M * 64; i += NT) { const int r = i >> 6, c = (i & 63) * 8;
        const int p = r < NCTXROWS ? (r & 255) : ((r - NCTXROWS) & 63), L = r < NCTXROWS ? 256 : 64;
        float a[8];
#pragma unroll
        for (int e = 0; e < 8; ++e) a[e] = cb[c + e];
#pragma unroll
        for (int j = 0; j < 4; ++j) { const int q = p + j - 2; if (q < 0 || q >= L) continue;
            const v4u w = *(const GAS v4u*)(PROJ + (size_t)(r + j - 2) * PIN + C_XB + c); const float* wj = cw + j * 512 + c;
            a[0] += bflo(w.x) * wj[0]; a[1] += bfhi(w.x) * wj[1]; a[2] += bflo(w.y) * wj[2]; a[3] += bfhi(w.y) * wj[3];
            a[4] += bflo(w.z) * wj[4]; a[5] += bfhi(w.z) * wj[5]; a[6] += bflo(w.w) * wj[6]; a[7] += bfhi(w.w) * wj[7]; }
        v4u o; o.x = pk2(a[0], a[1]); o.y = pk2(a[2], a[3]); o.z = pk2(a[4], a[5]); o.w = pk2(a[6], a[7]);
        *(GAS v4u*)(XC + (size_t)r * 512 + c) = o; }
}
__device__ __forceinline__ void rwkv_scan_naive(Frame& F, int l, int task, LAS float* scr) {
    const bool lat = task < 64; const int tt0 = lat ? task : task - 64; const int s = tt0 >> 4, d = (tt0 >> 3) & 1, h = tt0 & 7;
    const int T = lat ? DSEQ : SEQ; const int row0 = lat ? NCTXROWS + s * DSEQ : s * SEQ; const int lane = F.lane;
    const bf16* PROJ = (const bf16*)(F.ws + WS_PROJ); bf16* DEC = (bf16*)(F.ws + WS_DEC);
    float S[64];
    if (lat) { const float* sp = F.in[I_SRWKV] + ((((size_t)s * 4 + l) * 2 + d) * 8 + h) * 4096 + lane * 64;
#pragma unroll
        for (int j = 0; j < 64; j += 4) { const f32x4 v = *(const f32x4*)(sp + j); S[j] = v.x; S[j + 1] = v.y; S[j + 2] = v.z; S[j + 3] = v.w; } }
    else {
#pragma unroll
        for (int j = 0; j < 64; ++j) S[j] = 0.f; }
    const float kkw = F.in[I_RW_KK][l * 512 + h * 64 + lane], kaw = F.in[I_RW_KA][l * 512 + h * 64 + lane];
    for (int tt = 0; tt < T; ++tt) {
        const int t = d ? T - 1 - tt : tt; const size_t r = (size_t)(row0 + t);
        const float kj = bf2f(PROJ[r * PIN + C_K + h * 64 + lane]), rj = bf2f(PROJ[r * PIN + C_R + h * 64 + lane]), vi = bf2f(PROJ[r * PIN + C_V + h * 64 + lane]);
        const float lw = bf2f(DEC[r * NDEC + d * 512 + h * 64 + lane]), aj = bf2f(DEC[r * NDEC + 1024 + d * 512 + h * 64 + lane]);
        float kk = kj * kkw; const float nrm = wave_sum(kk * kk); kk *= 1.0f / sqrtf(nrm + 1e-12f);
        scr[lane] = kk; scr[64 + lane] = fexp(lw); scr[128 + lane] = kk * aj; scr[192 + lane] = kj * (1.0f + (aj - 1.0f) * kaw); scr[256 + lane] = rj;
        LDS_WAIT(); asm volatile("" ::: "memory");
        float sa0 = 0.f, sa1 = 0.f, sa2 = 0.f, sa3 = 0.f;
#pragma unroll
        for (int j = 0; j < 64; j += 4) { const f32x4 q = *(const LAS f32x4*)(scr + j); sa0 += S[j] * q.x; sa1 += S[j + 1] * q.y; sa2 += S[j + 2] * q.z; sa3 += S[j + 3] * q.w; }
        const float sa = (sa0 + sa1) + (sa2 + sa3);
        float y0 = 0.f, y1 = 0.f, y2 = 0.f, y3 = 0.f;
#pragma unroll
        for (int j = 0; j < 64; j += 4) { const f32x4 w = *(const LAS f32x4*)(scr + 64 + j), b = *(const LAS f32x4*)(scr + 128 + j), kd = *(const LAS f32x4*)(scr + 192 + j), rr = *(const LAS f32x4*)(scr + 256 + j);
            S[j] = S[j] * w.x - sa * b.x + vi * kd.x; S[j + 1] = S[j + 1] * w.y - sa * b.y + vi * kd.y; S[j + 2] = S[j + 2] * w.z - sa * b.z + vi * kd.z; S[j + 3] = S[j + 3] * w.w - sa * b.w + vi * kd.w;
            y0 += S[j] * rr.x; y1 += S[j + 1] * rr.y; y2 += S[j + 2] * rr.z; y3 += S[j + 3] * rr.w; }
        LDS_WAIT(); asm volatile("" ::: "memory");
        DEC[r * NDEC + d * 512 + h * 64 + lane] = (bf16)f2bf((y0 + y1) + (y2 + y3));
    }
    if (!lat) { float* op = F.out + O_SRWKV + ((((size_t)s * 4 + l) * 2 + d) * 8 + h) * 4096 + lane * 64;
#pragma unroll
        for (int j = 0; j < 64; j += 4) *(f32x4*)(op + j) = (f32x4){S[j], S[j + 1], S[j + 2], S[j + 3]}; }
}
__device__ __forceinline__ void lru_scan_naive(Frame& F, int l, int task) {
    const bool lat = task < 64; const int tt0 = lat ? task : task - 64; const int s = tt0 >> 4, d = (tt0 >> 3) & 1, cbk = tt0 & 7;
    const int T = lat ? DSEQ : SEQ; const int row0 = lat ? NCTXROWS + s * DSEQ : s * SEQ; const int c = cbk * 64 + F.lane;
    bf16* LRU = (bf16*)(F.ws + WS_LRU);
    float h = lat ? F.in[I_SLRU][(((size_t)s * 4 + l) * 2 + d) * 512 + c] : 0.f;
#pragma unroll 8
    for (int tt = 0; tt < T; ++tt) { const int t = d ? T - 1 - tt : tt; bf16* p = LRU + ((size_t)(row0 + t) * 2 + d) * 1024 + c;
        const float la = bf2f(p[0]), u = bf2f(p[512]); h = fexp(la) * h + u; p[512] = (bf16)f2bf(h); }
    if (!lat) F.out[O_SLRU + (((size_t)s * 4 + l) * 2 + d) * 512 + c] = h;
}
__device__ __forceinline__ void p_scan_naive(Frame& F, int l) {
    LAS float* scr = (LAS float*)(F.lds + RING_OFF + F.wave * 2048);
    const int gwt = F.wave * F.G + F.vcu, NGW = F.G * NWAVES;
    for (int t = gwt; t < 1152; t += NGW) {
        if (t < 64) rwkv_scan_naive(F, l, t, scr);
        else if (t < 128) lru_scan_naive(F, l, t - 64);
        else if (t < 640) rwkv_scan_naive(F, l, t - 128 + 64, scr);
        else lru_scan_naive(F, l, t - 640 + 64);
    }
}
__device__ __forceinline__ void ld8(const bf16* p, float (&o)[8]) { const v4u w = *(const GAS v4u*)p; o[0] = bflo(w.x); o[1] = bfhi(w.x); o[2] = bflo(w.y); o[3] = bfhi(w.y); o[4] = bflo(w.z); o[5] = bfhi(w.z); o[6] = bflo(w.w); o[7] = bfhi(w.w); }
__device__ __forceinline__ void ld8f(const float* p, float (&o)[8]) { const f32x4 a = *(const f32x4*)p, b = *(const f32x4*)(p + 4); o[0] = a.x; o[1] = a.y; o[2] = a.z; o[3] = a.w; o[4] = b.x; o[5] = b.y; o[6] = b.z; o[7] = b.w; }
__device__ __forceinline__ float sum8lanes(float v) { v += __shfl_xor(v, 1); v += __shfl_xor(v, 2); v += __shfl_xor(v, 4); return v; }
__device__ __forceinline__ void p_combine(Frame& F, int l) {
    const int gw = F.vcu * NWAVES + F.wave, NGW = F.G * NWAVES; const int lane = F.lane; const int c = lane * 8;
    const bf16* PROJ = (const bf16*)(F.ws + WS_PROJ); const bf16* DEC = (const bf16*)(F.ws + WS_DEC); const bf16* LRU = (const bf16*)(F.ws + WS_LRU); bf16* CAT = (bf16*)(F.ws + WS_XN);
    float lg[8], lb[8], ka[8], rk[8];
    ld8f(F.in[I_RW_LNXG] + l * 512 + c, lg); ld8f(F.in[I_RW_LNXB] + l * 512 + c, lb); ld8f(F.in[I_RW_KA] + l * 512 + c, ka); ld8f(F.in[I_RW_RK] + l * 512 + c, rk);
    for (int r = gw; r < M; r += NGW) {
        const bf16* pr = PROJ + (size_t)r * PIN; const bf16* dr = DEC + (size_t)r * NDEC; const bf16* lr = LRU + (size_t)r * 2048;
        float y0[8], y1[8], a0[8], a1[8], gg[8], rr[8], kk[8], vv[8], o[8];
        ld8(dr + c, y0); ld8(dr + 512 + c, y1); ld8(dr + 1024 + c, a0); ld8(dr + 1536 + c, a1); ld8(dr + 2048 + c, gg);
        ld8(pr + C_R + c, rr); ld8(pr + C_K + c, kk); ld8(pr + C_V + c, vv);
        float s = 0.f, bs = 0.f;
#pragma unroll
        for (int e = 0; e < 8; ++e) { o[e] = y0[e] + y1[e]; s += o[e]; bs += rr[e] * kk[e] * (2.0f + (a0[e] + a1[e] - 2.0f) * ka[e]) * rk[e]; }
        const float mu = sum8lanes(s) * (1.f / 64.f); const float bonus = sum8lanes(bs); float q = 0.f;
#pragma unroll
        for (int e = 0; e < 8; ++e) { o[e] -= mu; q += o[e] * o[e]; }
        const float rstd = 1.0f / sqrtf(sum8lanes(q) * (1.f / 64.f) + 64e-5f);
        float ya[8];
#pragma unroll
        for (int e = 0; e < 8; ++e) ya[e] = (o[e] * rstd * lg[e] + lb[e] + bonus * vv[e]) * gg[e];
        v4u w; w.x = pk2(ya[0], ya[1]); w.y = pk2(ya[2], ya[3]); w.z = pk2(ya[4], ya[5]); w.w = pk2(ya[6], ya[7]);
        *(GAS v4u*)(CAT + (size_t)r * D + c) = w;
        float h0[8], h1[8], gb[8];
        ld8(lr + 512 + c, h0); ld8(lr + 1024 + 512 + c, h1); ld8(pr + C_GB + c, gb);
#pragma unroll
        for (int e = 0; e < 8; ++e) ya[e] = bf2f((bf16)f2bf(h0[e] + h1[e])) * gelu_tanh(gb[e]);
        w.x = pk2(ya[0], ya[1]); w.y = pk2(ya[2], ya[3]); w.z = pk2(ya[4], ya[5]); w.w = pk2(ya[6], ya[7]);
        *(GAS v4u*)(CAT + (size_t)r * D + 512 + c) = w;
    }
}

constexpr int PH_PER_LAYER = 10, PH_PRO = 3, N_PHASES = PH_PRO + DEPTH * PH_PER_LAYER;
__global__ void __launch_bounds__(NWAVES * 64, 2) mk_fwd(Args args) {
    extern __shared__ __attribute__((aligned(16))) unsigned char lds[];
    Frame F;
    F.lds = (LAS unsigned char*)lds;
    F.tid = threadIdx.x; F.lane = F.tid & 63; F.wave = __builtin_amdgcn_readfirstlane(F.tid >> 6);
    F.G = gridDim.x; { const int bx = blockIdx.x; F.vcu = (F.G % 8 == 0) ? (bx % 8) * (F.G / 8) + bx / 8 : bx; }
    F.in = args.in; F.out = args.out; F.ws = args.ws;
    volatile LAS unsigned* MISC = (volatile LAS unsigned*)(F.lds + MISC_OFF);
    for (int u = F.tid; u < (LDS_BYTES - LDSCTL_OFF) / 4; u += NWAVES * 64) ((LAS unsigned*)(F.lds + LDSCTL_OFF))[u] = 0u;
    __syncthreads();
    const int lo = args.ph_lo, hi = args.ph_hi;
    XcdBarrier bar; bar.bar = (unsigned*)(F.ws + WS_CTL) + CW_BAR; bar.x = 0; bar.st = nullptr;
    if (hi - lo > 1) bar = xcd_barrier_post((unsigned*)(F.ws + WS_CTL) + CW_BAR, MISC + 8);
    bf16* XN = (bf16*)(F.ws + WS_XN); bf16* PROJ = (bf16*)(F.ws + WS_PROJ); bf16* DEC = (bf16*)(F.ws + WS_DEC); bf16* LRU = (bf16*)(F.ws + WS_LRU); bf16* AUX = LRU; bf16* ACT = PROJ; bf16* XC = XN;
    for (int ph = lo; ph < hi; ++ph) {
        { int t_ = threadIdx.x; asm volatile("" : "+v"(t_)); F.tid = t_; F.lane = t_ & 63; F.wave = __builtin_amdgcn_readfirstlane(t_ >> 6); }
        if (ph == 1000) {
            const bf16* src = (const bf16*)(F.ws + (MK_DBG_BUF == 0 ? WS_PROJ : MK_DBG_BUF == 1 ? WS_DEC : MK_DBG_BUF == 2 ? WS_LRU : WS_XN));
            const size_t gt = (size_t)(F.vcu * NWAVES + F.wave) * 64 + F.lane, NT = (size_t)F.G * NWAVES * 64;
            for (size_t i = gt; i < (size_t)16777216; i += NT) F.out[i] = bf2f(src[i]);
        } else
        if (ph == 0) { if (MK_EN & 1) p0_prologue(F); }
        else if (ph == 1) { if (MK_EN & 2) p1_modreduce(F); }
        else if (ph == 2) { if (MK_EN & 4) p_modnorm(F, 0, 0, true); }
        else {
            const int l = (ph - PH_PRO) / PH_PER_LAYER, s = (ph - PH_PRO) % PH_PER_LAYER;
            if (s == 0) { if (MK_EN & 8) {
                pg8::Gemm g{XN, wlayer(F, l, WL_IN), M, PIN, D, D, 0, 0}; pg8::StaticOrder S; S.init(M, PIN, F.G, (int)blockIdx.x);
                pg8::EpiProj E{PROJ, AUX};
                pg8::gemm_phase<pg8::EpiProj, pg8::StaticOrder, true, true>(F.lds + RING_OFF, g, S, E);
            } } else if (s == 1) { if (MK_EN & 16) {
                { pg8::Gemm g{AUX, wlayer(F, l, WL_AUX), M, NDEC, NAUX, NAUX, 0, 0}; pg8::StaticOrder S; S.init(M, NDEC, F.G, (int)blockIdx.x);
                  pg8::EpiDec E{DEC, F.in[I_RW_W0] + l * 1024, F.in[I_RW_A0] + l * 1024};
                  pg8::gemm_phase<pg8::EpiDec, pg8::StaticOrder, true, true>(F.lds + RING_OFF, g, S, E); }
                p_lruconv(F, l);
            } } else if (s == 2) { if (MK_EN & 32) {
                pg8::Gemm g{XC, wlayer(F, l, WL_LRU), M, NLRU, 256, 512, 256, 2}; pg8::StaticOrder S; S.init(M, NLRU, F.G, (int)blockIdx.x);
                pg8::EpiLru E{LRU, XC, F.in[I_LRU_GAB] + l * 1024, F.in[I_LRU_GXB] + l * 1024, (const float*)(F.ws + WS_SPT) + l * 1024};
                pg8::gemm_phase<pg8::EpiLru, pg8::StaticOrder, true, true>(F.lds + RING_OFF, g, S, E);
            } } else if (s == 3) { if (MK_EN & 64) p_scan_naive(F, l); }
            else if (s == 4) { if (MK_EN & 128) p_combine(F, l); }
            else if (s == 5) { if (MK_EN & 256) {
                pg8::Gemm g{XN, wlayer(F, l, WL_OUT), M, D, D, D, 0, 0}; pg8::StaticOrder S; S.init(M, D, F.G, (int)blockIdx.x);
                pg8::EpiRes E{l == 0 ? F.in[I_XP] : F.out, l == 0 ? F.in[I_XS] : F.out + (size_t)NCTXROWS * D, F.out, modp(F, l, 0) + 2048};
                pg8::gemm_phase<pg8::EpiRes, pg8::StaticOrder, true, true>(F.lds + RING_OFF, g, S, E);
            } } else if (s == 6) { if (MK_EN & 512) p_modnorm(F, l, 1, false); }
            else if (s == 7) { if (MK_EN & 1024) {
                pg8::Gemm g{XN, wlayer(F, l, WL_UP), M, 2 * DFF, D, D, 0, 0}; pg8::StaticOrder S; S.init(M, 2 * DFF, F.G, (int)blockIdx.x);
                pg8::EpiFfn E{ACT, F.in[I_FCW] + (size_t)l * 3 * 5632, F.in[I_FCB] + (size_t)l * 5632, (PG8_LAS float*)(F.lds + XBUF_OFF)};
                pg8::gemm_phase<pg8::EpiFfn, pg8::StaticOrder, true, true>(F.lds + RING_OFF, g, S, E);
            } } else if (s == 8) { if (MK_EN & 2048) {
                pg8::Gemm g{ACT, wlayer(F, l, WL_DOWN), M, D, DFF, DFF, 0, 0}; pg8::StaticOrder S; S.init(M, D, F.G, (int)blockIdx.x);
                pg8::EpiRes E{F.out, F.out + (size_t)NCTXROWS * D, F.out, modp(F, l, 0) + 5120};
                pg8::gemm_phase<pg8::EpiRes, pg8::StaticOrder, true, true>(F.lds + RING_OFF, g, S, E);
            } } else { if (MK_EN & 4096) {
                if (l + 1 < DEPTH) p_modnorm(F, l + 1, 0, false); else p_finalnorm(F);
            } }
        }
        if (ph + 1 < hi) xcd_barrier(bar);
    }
}

extern "C" void kernel_launch(void* const* d_in, const int* in_sizes, int n_in, void* d_out, int out_size, void* d_ws, size_t ws_size, hipStream_t stream) {
    static int grid = 0;
    if (grid == 0) {
        if (n_in != N_IN || (size_t)out_size != OUT_TOTAL || ws_size < WS_END) { fprintf(stderr, "kernel_launch: unexpected shapes: n_in %d out %d ws %zu\n", n_in, out_size, ws_size); grid = -1; return; }
        int dev = 0, cus = 0;
        if (hipGetDevice(&dev) != hipSuccess || hipDeviceGetAttribute(&cus, hipDeviceAttributeMultiprocessorCount, dev) != hipSuccess) { grid = -1; return; }
        if (hipFuncSetAttribute((const void*)mk_fwd, hipFuncAttributeMaxDynamicSharedMemorySize, LDS_BYTES) != hipSuccess) { grid = -1; return; }
        (void)hipGetLastError();
        grid = cus;
    }
    if (grid < 0) return;
    (void)hipMemsetAsync((char*)d_ws + WS_CTL, 0, CTL_ZERO_BYTES, stream);
    Args a{};
    for (int i = 0; i < N_IN; ++i) a.in[i] = (const float*)d_in[i];
    a.out = (float*)d_out; a.ws = (unsigned char*)d_ws;
#if MK_ONE_LAUNCH
    a.ph_lo = 0; a.ph_hi = N_PHASES;
    hipLaunchKernelGGL(mk_fwd, dim3(grid), dim3(NWAVES * 64), LDS_BYTES, stream, a);
#else
    const int nph = MK_DBG_STOP ? MK_DBG_STOP : N_PHASES;
    for (int ph = 0; ph < nph; ++ph) { a.ph_lo = ph; a.ph_hi = ph + 1; hipLaunchKernelGGL(mk_fwd, dim3(grid), dim3(NWAVES * 64), LDS_BYTES, stream, a); }
    if (MK_DBG_STOP) { a.ph_lo = 1000; a.ph_hi = 1001; hipLaunchKernelGGL(mk_fwd, dim3(grid), dim3(NWAVES * 64), LDS_BYTES, stream, a); }
#endif
}
```

```cpp
#include <hip/hip_runtime.h>
#include <cstdio>
#include <cstdint>
#define MK_ONE_LAUNCH 1
namespace pg8 {
#define PG8_LAS __attribute__((address_space(3)))
typedef unsigned short bf16_t;
typedef short bf16x8 __attribute__((ext_vector_type(8)));
typedef float f32x4 __attribute__((ext_vector_type(4)));
typedef unsigned u32x4 __attribute__((ext_vector_type(4)));
constexpr int BM = 256, BK = 64, HALF = 128, HTB = HALF * BK * 2  , STAGE_BYTES = 8 * HTB, NXCD = 8, WGM = 8;

__host__ __device__ __forceinline__ int lds_byte(int r, int c) { const int st = (r >> 4) * 2 + (c >> 5), rr = r & 15, cc = c & 31, ob = rr * 64 + cc * 2; return st * 1024 + (ob ^ (((ob >> 9) & 1) << 5)); }
__host__ __device__ __forceinline__ void stage_rc(int b, int& R, int& C) { const int st = b / 1024, sb = b % 1024, swz = sb ^ (((sb >> 9) & 1) << 5); R = (st >> 1) * 16 + swz / 64; C = (st & 1) * 32 + (swz % 64) / 2; }
__host__ __device__ __forceinline__ int perm32(int rho) { const int n = rho >> 4, i = rho & 15; return 8 * (i >> 2) + 4 * n + (i & 3); }

struct Unit { int pm, pn; };
struct Gemm { const bf16_t* A; const bf16_t* Bt; int M, N, K; int lda; int apn; int apsh; };

struct StaticOrder {
    int nM, nN, nwg, G, c;
    __host__ __device__ void init(int M, int N, int G_, int c_) { nM = M / BM; nN = N / BM; nwg = nM * nN; G = G_; c = c_; }
    __host__ __device__ bool next(int i, Unit& u) const {
        const long L = (long)i * G + c; if (L >= nwg) return false;
        int wgid = (int)L; { const int q = nwg / NXCD, r = nwg % NXCD, xcd = wgid % NXCD, off = wgid / NXCD; wgid = (xcd < r ? xcd * (q + 1) : r * (q + 1) + (xcd - r) * q) + off; }
        const int nig = WGM * nN, gid = wgid / nig, fm = gid * WGM, gsz = (nM - fm) < WGM ? (nM - fm) : WGM;
        u.pm = fm + ((wgid % nig) % gsz); u.pn = (wgid % nig) / gsz; return true;
    }
    __device__ __forceinline__ void a_ready(const Unit&) const {}
    __device__ __forceinline__ void done(const Unit&) const {}
};

typedef __bf16 bf16x2_hw __attribute__((ext_vector_type(2)));
typedef float f32x2_cv __attribute__((ext_vector_type(2)));
__device__ __forceinline__ unsigned cvt_pk_bf16(float lo, float hi) { const f32x2_cv v = {lo, hi}; return __builtin_bit_cast(unsigned, __builtin_convertvector(v, bf16x2_hw)); }
typedef float f32x2 __attribute__((ext_vector_type(2)));
__device__ __forceinline__ f32x2 gelu_pk(f32x2 v) {
    const f32x2 av = __builtin_elementwise_abs(v), d = av * 0.2316418882f + 1.0f;
    f32x2 t; t.x = __builtin_amdgcn_rcpf(d.x); t.y = __builtin_amdgcn_rcpf(d.y);
    f32x2 q = t * 0.5307027145f + (-0.7265760135f); q = q * t + 0.7107068705f; q = q * t + (-0.142248368f); q = q * t + 0.127414796f; q = q * t;
    const f32x2 s = (v * v) * (-0.72134752044f);
    f32x2 e; e.x = __builtin_amdgcn_exp2f(s.x); e.y = __builtin_amdgcn_exp2f(s.y);
    const f32x2 m = v * (q * e), r = v - m;
    f32x2 o; o.x = v.x < 0.f ? m.x : r.x; o.y = v.y < 0.f ? m.y : r.y; return o;
}

template <int ACT  > struct EpiBf16 {
    static constexpr bool PERM = true, AFTER_DRAIN = false; static_assert(ACT == 0 || ACT == 1, "EpiBf16: ACT is 0 (none) or 1 (gelu_pk)");
    bf16_t* O; int ldc; const float* bias; int split_cols; size_t split_stride; float scale0;
    __device__ __forceinline__ void operator()(const f32x4 (&acc)[2][2][4][2], const Unit& u, int wr, int wc, int fr, int fq) const {
        const int row0 = u.pm * BM + wr * 64 + fr; int colt = u.pn * BM; bf16_t* base = O;
        float sc = 1.f; if (split_cols) { const int t = colt / split_cols; base += (size_t)t * split_stride; colt -= t * split_cols; if (t == 0) sc = scale0; }
        const int col0 = colt + wc * 32 + 8 * fq, bcol0 = u.pn * BM + wc * 32 + 8 * fq;
        f32x4 bv[2][2];
#pragma unroll
        for (int bj = 0; bj < 2; ++bj)
#pragma unroll
            for (int n = 0; n < 2; ++n) bv[bj][n] = bias ? *(const f32x4*)(bias + bcol0 + bj * HALF + 4 * n) : (f32x4){0.f, 0.f, 0.f, 0.f};
#pragma unroll
        for (int ai = 0; ai < 2; ++ai)
#pragma unroll
            for (int m = 0; m < 4; ++m) { bf16_t* rowp = base + (size_t)(row0 + ai * HALF + m * 16) * ldc + col0;
#pragma unroll
                for (int bj = 0; bj < 2; ++bj) { f32x4 v0 = acc[ai][bj][m][0] + bv[bj][0], v1 = acc[ai][bj][m][1] + bv[bj][1];
                    if (ACT == 1) { f32x2 a = gelu_pk((f32x2){v0[0], v0[1]}), b = gelu_pk((f32x2){v0[2], v0[3]}), c = gelu_pk((f32x2){v1[0], v1[1]}), d = gelu_pk((f32x2){v1[2], v1[3]});
                        v0 = (f32x4){a.x, a.y, b.x, b.y}; v1 = (f32x4){c.x, c.y, d.x, d.y}; }
                    v0 = v0 * sc; v1 = v1 * sc; u32x4 w; w.x = cvt_pk_bf16(v0[0], v0[1]); w.y = cvt_pk_bf16(v0[2], v0[3]); w.z = cvt_pk_bf16(v1[0], v1[1]); w.w = cvt_pk_bf16(v1[2], v1[3]);
                    *(u32x4*)(rowp + bj * HALF) = w; } }
    }
};

template <class Epi, class Sched, bool ALIGN_EPI = false, bool SP2 = false>
__device__ __forceinline__ void gemm_phase(PG8_LAS unsigned char* lds, const Gemm g, const Sched& S, const Epi& E) {
    int tid_ = threadIdx.x; asm volatile("" : "+v"(tid_));
    const int tid = tid_, wid = __builtin_amdgcn_readfirstlane(tid >> 6), lane = tid & 63, wr = wid >> 2, wc = wid & 3, fr = lane & 15, fq = lane >> 4;
    int K_ = g.K; asm volatile("" : "+s"(K_));
    const int K = K_, nt = K / BK;
    unsigned voffA[2], voffB[2];
#pragma unroll
    for (int i = 0; i < 2; ++i) { int R, C; stage_rc(tid * 16 + i * 8192, R, C); const int Rb = Epi::PERM ? ((R & ~31) + perm32(R & 31)) : R;
        voffA[i] = (unsigned)(R * g.lda + C) * 2u; voffB[i] = (unsigned)(Rb * K + C) * 2u; }
    const size_t kstep = (size_t)(BK * 2);
    const size_t hstepA = (size_t)HALF * g.lda * 2, hstepB = (size_t)HALF * K * 2;
    const size_t tstepA = 2 * hstepA, tstepB = 2 * hstepB, apnb = (size_t)g.apn * 2;
    const unsigned ldsw = (unsigned)wid * 1024u;
    const int aoff = lds_byte(wr * 64 + fr, fq * 8), boff = lds_byte(wc * 32 + fr, fq * 8);
#define PG8_SA(b, h) (((b) * 2 + (h)) * HTB)
#define PG8_SB(b, h) ((4 + (b) * 2 + (h)) * HTB)
#define PG8_STAGE(bufoff, gbase, voff) do { _Pragma("unroll") for (int _i = 0; _i < 2; ++_i) \
        __builtin_amdgcn_global_load_lds((const unsigned*)((const char*)(gbase) + (voff)[_i]), (PG8_LAS unsigned*)(lds + (bufoff) + ldsw + _i * 8192), 16, 0, 0); } while (0)
#define PG8_LDA(dst, b, h) do { _Pragma("unroll") for (int m = 0; m < 4; ++m) _Pragma("unroll") for (int k = 0; k < 2; ++k) dst[m][k] = *(const PG8_LAS bf16x8*)(lds + PG8_SA(b, h) + aoff + m * 2048 + k * 1024); } while (0)
#define PG8_LDB(dst, b, h) do { _Pragma("unroll") for (int n = 0; n < 2; ++n) _Pragma("unroll") for (int k = 0; k < 2; ++k) dst[n][k] = *(const PG8_LAS bf16x8*)(lds + PG8_SB(b, h) + boff + n * 2048 + k * 1024); } while (0)
#define PG8_MMA(ai, bj, At, Bt) do { __builtin_amdgcn_s_setprio(1); _Pragma("unroll") for (int m = 0; m < 4; ++m) _Pragma("unroll") for (int n = 0; n < 2; ++n) _Pragma("unroll") for (int k = 0; k < 2; ++k) \
        acc[ai][bj][m][n] = __builtin_amdgcn_mfma_f32_16x16x32_bf16(Bt[n][k], At[m][k], acc[ai][bj][m][n], 0, 0, 0); __builtin_amdgcn_s_setprio(0); } while (0)
#define PG8_WAIT_V(n) asm volatile("s_waitcnt vmcnt(" #n ")" ::: "memory")
#define PG8_WAIT_L(n) asm volatile("s_waitcnt lgkmcnt(" #n ")" ::: "memory")
#define PG8_BAR __builtin_amdgcn_s_barrier()
#define PG8_SCHED __builtin_amdgcn_sched_barrier(0)
    Unit cur, nxt; int ui = 0;
    if (!S.next(0, cur)) return;
    f32x4 acc[2][2][4][2];
#pragma unroll
    for (int a = 0; a < 2; ++a)
#pragma unroll
        for (int b = 0; b < 2; ++b)
#pragma unroll
            for (int m = 0; m < 4; ++m)
#pragma unroll
                for (int n = 0; n < 2; ++n) acc[a][b][m][n] = (f32x4){0.f, 0.f, 0.f, 0.f};
    bf16x8 At[4][2], B0[2][2], B1[2][2];
    const char* cA = (const char*)g.A + (size_t)cur.pm * tstepA + (size_t)(cur.pn >> g.apsh) * apnb; const char* cB = (const char*)g.Bt + (size_t)cur.pn * tstepB;
    S.a_ready(cur);
    if constexpr (SP2) {
        PG8_STAGE(PG8_SB(0, 0), cB, voffB); PG8_STAGE(PG8_SB(0, 1), cB + hstepB, voffB); PG8_STAGE(PG8_SA(0, 0), cA, voffA); PG8_STAGE(PG8_SA(0, 1), cA + hstepA, voffA);
        if (wr == 1) PG8_BAR;
        PG8_WAIT_V(2); PG8_BAR;
        PG8_STAGE(PG8_SB(1, 0), cB + kstep, voffB); PG8_STAGE(PG8_SA(1, 0), cA + kstep, voffA); PG8_STAGE(PG8_SB(1, 1), cB + hstepB + kstep, voffB);
        PG8_WAIT_V(6); PG8_BAR;
    } else {
        PG8_STAGE(PG8_SB(0, 0), cB, voffB); PG8_STAGE(PG8_SA(0, 0), cA, voffA); PG8_STAGE(PG8_SB(0, 1), cB + hstepB, voffB); PG8_STAGE(PG8_SA(0, 1), cA + hstepA, voffA);
        if (wr == 1) PG8_BAR;
        PG8_WAIT_V(4); PG8_BAR;
        PG8_STAGE(PG8_SB(1, 0), cB + kstep, voffB); PG8_STAGE(PG8_SA(1, 0), cA + kstep, voffA); PG8_STAGE(PG8_SB(1, 1), cB + hstepB + kstep, voffB);
        PG8_WAIT_V(6); PG8_BAR;
    }
    for (;;) {
        const bool has_next = S.next(ui + 1, nxt);
        const char* nA = has_next ? (const char*)g.A + (size_t)nxt.pm * tstepA + (size_t)(nxt.pn >> g.apsh) * apnb : cA; const char* nB = has_next ? (const char*)g.Bt + (size_t)nxt.pn * tstepB : cB;
        for (int t = 0; t < nt; t += 2) {
            const bool last = (t == nt - 2);
            const char* a1 = cA + (size_t)(t + 1) * kstep;
            const char* a2 = last ? nA : cA + (size_t)(t + 2) * kstep; const char* b2 = last ? nB : cB + (size_t)(t + 2) * kstep;
            const char* a3 = a2 + kstep; const char* b3 = b2 + kstep;
            if (last && has_next) S.a_ready(nxt);
            if constexpr (SP2) {
            PG8_LDB(B0, 0, 0); PG8_LDB(B1, 0, 1); PG8_SCHED; PG8_LDA(At, 0, 0); PG8_STAGE(PG8_SA(1, 1), a1 + hstepA, voffA);
            PG8_WAIT_V(8); PG8_WAIT_L(0); PG8_BAR; PG8_MMA(0, 0, At, B0); PG8_MMA(0, 1, At, B1); PG8_BAR; PG8_SCHED;
            PG8_LDA(At, 0, 1); PG8_STAGE(PG8_SB(0, 0), b2, voffB); PG8_STAGE(PG8_SB(0, 1), b2 + hstepB, voffB); PG8_STAGE(PG8_SA(0, 0), a2, voffA);
            PG8_WAIT_V(8); PG8_WAIT_L(0); PG8_BAR; PG8_MMA(1, 0, At, B0); PG8_MMA(1, 1, At, B1); PG8_BAR; PG8_SCHED;
            PG8_LDB(B0, 1, 0); PG8_LDB(B1, 1, 1); PG8_SCHED; PG8_LDA(At, 1, 0); PG8_STAGE(PG8_SA(0, 1), a2 + hstepA, voffA);
            PG8_WAIT_V(8); PG8_WAIT_L(0); PG8_BAR; PG8_MMA(0, 0, At, B0); PG8_MMA(0, 1, At, B1); PG8_BAR; PG8_SCHED;
            PG8_LDA(At, 1, 1); PG8_STAGE(PG8_SB(1, 0), b3, voffB); PG8_STAGE(PG8_SB(1, 1), b3 + hstepB, voffB); PG8_STAGE(PG8_SA(1, 0), a3, voffA);
            PG8_WAIT_V(8); PG8_WAIT_L(0); PG8_BAR; PG8_MMA(1, 0, At, B0); PG8_MMA(1, 1, At, B1); PG8_BAR; PG8_SCHED;
            } else {
            PG8_LDB(B0, 0, 0); PG8_SCHED; PG8_LDA(At, 0, 0); PG8_STAGE(PG8_SA(1, 1), a1 + hstepA, voffA);
            PG8_WAIT_L(8); PG8_BAR; PG8_WAIT_L(0); PG8_MMA(0, 0, At, B0); PG8_BAR; PG8_SCHED;
            PG8_LDB(B1, 0, 1); PG8_STAGE(PG8_SB(0, 0), b2, voffB);
            PG8_BAR; PG8_WAIT_L(0); PG8_MMA(0, 1, At, B1); PG8_BAR;
            PG8_LDA(At, 0, 1); PG8_STAGE(PG8_SA(0, 0), a2, voffA);
            PG8_BAR; PG8_WAIT_L(0); PG8_MMA(1, 0, At, B0); PG8_BAR; PG8_SCHED;
            PG8_STAGE(PG8_SB(0, 1), b2 + hstepB, voffB);
            PG8_WAIT_V(6); PG8_BAR; PG8_MMA(1, 1, At, B1); PG8_BAR;
            PG8_LDB(B0, 1, 0); PG8_SCHED; PG8_LDA(At, 1, 0); PG8_STAGE(PG8_SA(0, 1), a2 + hstepA, voffA);
            PG8_WAIT_L(8); PG8_BAR; PG8_WAIT_L(0); PG8_MMA(0, 0, At, B0); PG8_BAR; PG8_SCHED;
            PG8_LDB(B1, 1, 1); PG8_STAGE(PG8_SB(1, 0), b3, voffB);
            PG8_BAR; PG8_WAIT_L(0); PG8_MMA(0, 1, At, B1); PG8_BAR;
            PG8_LDA(At, 1, 1); PG8_STAGE(PG8_SA(1, 0), a3, voffA);
            PG8_BAR; PG8_WAIT_L(0); PG8_MMA(1, 0, At, B0); PG8_BAR; PG8_SCHED;
            PG8_STAGE(PG8_SB(1, 1), b3 + hstepB, voffB);
            PG8_WAIT_V(6); PG8_BAR; PG8_MMA(1, 1, At, B1); PG8_BAR;
            }
        }
        if constexpr (ALIGN_EPI) { if (wr == 0) PG8_BAR; }
        if constexpr (!Epi::AFTER_DRAIN) { E(acc, cur, wr, wc, fr, fq); S.done(cur); }
        if (!has_next) break;
#pragma unroll
        for (int a = 0; a < 2; ++a)
#pragma unroll
            for (int b = 0; b < 2; ++b)
#pragma unroll
                for (int m = 0; m < 4; ++m)
#pragma unroll
                    for (int n = 0; n < 2; ++n) acc[a][b][m][n] = (f32x4){0.f, 0.f, 0.f, 0.f};
        cur = nxt; cA = nA; cB = nB; ++ui;
        if constexpr (ALIGN_EPI) { if (wr == 1) PG8_BAR; }
    }
    PG8_WAIT_V(0);
    if constexpr (!ALIGN_EPI) { if (wr == 0) PG8_BAR; }
    PG8_BAR;
    if constexpr (Epi::AFTER_DRAIN) { E.fused(acc, cur, wr, wc, fr, fq, lds, wid, lane); S.done(cur); }
#undef PG8_SA
#undef PG8_SB
#undef PG8_STAGE
#undef PG8_LDA
#undef PG8_LDB
#undef PG8_MMA
#undef PG8_WAIT_V
#undef PG8_WAIT_L
#undef PG8_BAR
#undef PG8_SCHED
}
}

#ifndef MK_EN
#define MK_EN 0xFFFF
#endif
#ifndef MK_DBG_STOP
#define MK_DBG_STOP 0
#endif
#ifndef MK_DBG_BUF
#define MK_DBG_BUF 0
#endif
#ifndef MK_ONE_LAUNCH
#define MK_ONE_LAUNCH 0
#endif
#define GAS __attribute__((address_space(1)))
#define LAS __attribute__((address_space(3)))
typedef unsigned short bf16;
typedef unsigned v4u __attribute__((ext_vector_type(4)));
typedef unsigned v2u __attribute__((ext_vector_type(2)));
typedef float f32x4 __attribute__((ext_vector_type(4)));
typedef float f32x2 __attribute__((ext_vector_type(2)));
#define RLX_AGENT __ATOMIC_RELAXED, __HIP_MEMORY_SCOPE_AGENT
#define LDS_WAIT() asm volatile("s_waitcnt lgkmcnt(0)" ::: "memory")
#define VM_WAIT() asm volatile("s_waitcnt vmcnt(0)" ::: "memory")

constexpr int NWAVES = 8;
constexpr int D = 1024, M = 16384, NCTXROWS = 8192, DEPTH = 4, SEQ = 256, DSEQ = 2048, NB = 32, NDB = 4;
constexpr int PIN = 2816, DFF = 2816, NDEC = 2560, NAUX = 256, NLRU = 2048;
constexpr int C_R = 0, C_K = 512, C_V = 1024, C_XW = 1536, C_XB = 1792, C_GB = 2304;
constexpr float DECAY_SCALE = 0.6065306597126334f;
enum { I_XP = 0, I_XS, I_SRWKV, I_SLRU, I_C, I_CCTX, I_LN1G, I_WMOD, I_BMOD, I_WIN, I_RW_W0, I_RW_WUP, I_RW_A0, I_RW_AUP, I_RW_GUP, I_RW_KK, I_RW_KA, I_RW_RK,
       I_RW_LNXG, I_RW_LNXB, I_LRU_CW, I_LRU_CB, I_LRU_GAW, I_LRU_GAB, I_LRU_GXW, I_LRU_GXB, I_LRU_LAM, I_WOUT, I_LN2G, I_WUP, I_FCW, I_FCB, I_WDOWN, I_LNFG, N_IN };
constexpr size_t O_Y = 0, O_SRWKV = 16777216, O_SLRU = 16777216 + 8388608, OUT_TOTAL = 16777216 + 8388608 + 131072;
constexpr size_t MiB = 1u << 20;
constexpr size_t WS_CTL = 0, CTL_ZERO_BYTES = 1 * MiB;
constexpr size_t WS_MOD = 1 * MiB;
constexpr size_t WS_SPT = 1 * MiB + 512 * 1024;
constexpr size_t WS_MODP = 2 * MiB;
constexpr size_t WS_W = 8 * MiB;
constexpr size_t WL_STRIDE = 26 * MiB + MiB / 4, WL_IN = 0, WL_OUT = 5 * MiB + MiB / 2, WL_UP = WL_OUT + 2 * MiB, WL_DOWN = WL_UP + 11 * MiB, WL_AUX = WL_DOWN + 5 * MiB + MiB / 2, WL_LRU = WL_AUX + MiB + MiB / 4;
static_assert(WL_LRU + 1 * MiB == WL_STRIDE, "weight map");
constexpr size_t WS_XN = WS_W + 4 * WL_STRIDE;
constexpr size_t WS_PROJ = WS_XN + 32 * MiB;
constexpr size_t WS_DEC = WS_PROJ + 88 * MiB;
constexpr size_t WS_LRU = WS_DEC + 80 * MiB;
constexpr size_t WS_END = WS_LRU + 64 * MiB;
static_assert(WS_END == 377 * MiB, "ws map");
constexpr int CW_BAR = 4096;

__device__ __forceinline__ unsigned f2bf(float f) { unsigned u = __builtin_bit_cast(unsigned, f); return (u + 0x7fffu + ((u >> 16) & 1u)) >> 16; }
__device__ __forceinline__ unsigned pk2(float lo, float hi) { return pg8::cvt_pk_bf16(lo, hi); }
__device__ __forceinline__ float bflo(unsigned w) { return __builtin_bit_cast(float, w << 16); }
__device__ __forceinline__ float bfhi(unsigned w) { return __builtin_bit_cast(float, w & 0xffff0000u); }
__device__ __forceinline__ float bf2f(bf16 h) { return __builtin_bit_cast(float, (unsigned)h << 16); }
__device__ __forceinline__ float fsigmoid(float x) { return __builtin_amdgcn_rcpf(1.0f + __builtin_amdgcn_exp2f(-1.4426950409f * x)); }
__device__ __forceinline__ float ftanh(float x) { return 2.0f * fsigmoid(2.0f * x) - 1.0f; }
__device__ __forceinline__ float gelu_tanh(float x) { const float z = 0.7978845608f * (x + 0.044715f * x * x * x); return x * fsigmoid(2.0f * z); }
__device__ __forceinline__ float fexp(float x) { return __builtin_amdgcn_exp2f(1.4426950409f * x); }
__device__ __forceinline__ float wave_sum(float v) {
#pragma unroll
    for (int o = 1; o < 64; o <<= 1) v += __shfl_xor(v, o);
    return v;
}

#define XB_TMO      128
#define XB_XCNT(j)  (256  + 64 * (j))
#define XB_XSUB(j)  (1280 + 64 * (j))
#define XB_XGEN(j)  (2304 + 64 * (j))
#define XB_TOP      3328
#define XB_TOPGEN   3392
#define XCD_BAR_WORDS 3456
#define XB_SPIN_CAP (1u << 20)
__device__ __forceinline__ unsigned xb_ld(unsigned* p)              { return __hip_atomic_load(p, __ATOMIC_RELAXED, __HIP_MEMORY_SCOPE_AGENT); }
__device__ __forceinline__ unsigned xb_add(unsigned* p, unsigned v) { return __hip_atomic_fetch_add(p, v, __ATOMIC_RELAXED, __HIP_MEMORY_SCOPE_AGENT); }
__device__ __forceinline__ unsigned xb_xcc_id() { return (unsigned)__builtin_amdgcn_s_getreg((3 << 11) | 20) & 0xFu; }
#define XB_SPIN(cond, bar) do { unsigned _sp = 0; while (cond) { __builtin_amdgcn_s_sleep(1); \
    if ((++_sp & 255u) == 0u) { if (xb_ld(&(bar)[XB_TMO])) break; if (_sp > XB_SPIN_CAP) { atomicAdd(&(bar)[XB_TMO], 1u); break; } } } } while (0)
struct XcdBarrier { unsigned* bar; unsigned x; volatile LAS unsigned* st; };
__device__ __forceinline__ XcdBarrier xcd_barrier_post(unsigned* bar, volatile LAS unsigned* st) {
    XcdBarrier b; b.bar = bar; b.x = xb_xcc_id(); b.st = st;
    if (threadIdx.x == 0) (void)xb_add(&bar[XB_XCNT(b.x)], 1u);
    return b;
}
__device__ __forceinline__ void xcd_barrier_complete(unsigned* bar, unsigned x, unsigned& nloc, unsigned& nx) {
    const unsigned G = gridDim.x * gridDim.y * gridDim.z;
    unsigned sum, cnt, mine, sp = 0u;
    for (;;) {
        sum = 0u; cnt = 0u; mine = 0u;
#pragma unroll
        for (unsigned j = 0; j < 16; ++j) { const unsigned c = xb_ld(&bar[XB_XCNT(j)]); sum += c; cnt += (c > 0u) ? 1u : 0u; mine = (j == x) ? c : mine; }
        if (sum == G) break;
        __builtin_amdgcn_s_sleep(1);
        if ((++sp & 255u) == 0u) { if (xb_ld(&bar[XB_TMO])) break; if (sp > XB_SPIN_CAP) { atomicAdd(&bar[XB_TMO], 1u); break; } }
    }
    nloc = mine > 0u ? mine : 1u; nx = cnt > 0u ? cnt : 1u;
}
__device__ __forceinline__ void xcd_barrier(const XcdBarrier& b) {
    asm volatile("s_waitcnt vmcnt(0)" ::: "memory");
    __syncthreads();
    if (threadIdx.x == 0) {
        unsigned* bar = b.bar;
        __builtin_amdgcn_s_waitcnt(0);
        unsigned nloc = b.st[0], nx = b.st[1];
        if (nloc == 0u) { xcd_barrier_complete(bar, b.x, nloc, nx); b.st[0] = nloc; b.st[1] = nx; }
        const unsigned old = xb_add(&bar[XB_XSUB(b.x)], 1u);
        const unsigned gen = old / nloc;
        if (old + 1u == (gen + 1u) * nloc) {
            __builtin_amdgcn_fence(__ATOMIC_RELEASE, "agent");
            asm volatile("s_waitcnt vmcnt(0)" ::: "memory");
            const unsigned og = xb_add(&bar[XB_TOP], 1u);
            const unsigned tg = og / nx;
            if (og + 1u == (tg + 1u) * nx) xb_add(&bar[XB_TOPGEN], 1u);
            else XB_SPIN(xb_ld(&bar[XB_TOPGEN]) == tg, bar);
            __builtin_amdgcn_fence(__ATOMIC_ACQUIRE, "agent");
            xb_add(&bar[XB_XGEN(b.x)], 1u);
            asm volatile("s_waitcnt vmcnt(0)" ::: "memory");
        } else {
            XB_SPIN(xb_ld(&bar[XB_XGEN(b.x)]) == gen, bar);
            __builtin_amdgcn_fence(__ATOMIC_ACQUIRE, "agent");
            asm volatile("s_waitcnt vmcnt(0)" ::: "memory");
        }
    }
    __syncthreads();
}

constexpr int RING_OFF = 0, RING_BYTES = 131072;
constexpr int XBUF_OFF = RING_BYTES;
constexpr int LDSCTL_OFF = RING_BYTES + 8192, MISC_OFF = LDSCTL_OFF + 320;
constexpr int LDS_BYTES = 147456;
static_assert(MISC_OFF + 128 <= LDS_BYTES, "LDS map");

struct Args { const float* in[N_IN]; float* out; unsigned char* ws; int ph_lo, ph_hi; };
static_assert(sizeof(Args) == N_IN * 8 + 24, "Args has no padding");

struct Frame {
    LAS unsigned char* lds;
    int tid, lane, wave, vcu, G;
    const float* const* in;
    float* out; unsigned char* ws;
};
__device__ __forceinline__ bf16* wlayer(const Frame& F, int l, size_t off) { return (bf16*)(F.ws + WS_W + (size_t)l * WL_STRIDE + off); }
__device__ __forceinline__ const float* modp(const Frame& F, int l, int bi) { return (const float*)(F.ws + WS_MOD) + ((size_t)l * 5 + bi) * 6144; }
__device__ __forceinline__ int row_bidx(int r) { return r < NCTXROWS ? 0 : 1 + ((r - NCTXROWS) >> 11); }

namespace pg8 {
struct EpiProj {
    static constexpr bool PERM = true, AFTER_DRAIN = false;
    bf16_t* O; bf16_t* AUX;
    __device__ __forceinline__ void operator()(const f32x4 (&acc)[2][2][4][2], const Unit& u, int wr, int wc, int fr, int fq) const {
        const int row0 = u.pm * BM + wr * 64 + fr; const int ct0 = wc * 32 + 8 * fq; const int col0 = u.pn * BM + ct0;
#pragma unroll
        for (int ai = 0; ai < 2; ++ai)
#pragma unroll
            for (int m = 0; m < 4; ++m) { const size_t row = (size_t)(row0 + ai * HALF + m * 16); bf16_t* rowp = O + row * PIN + col0;
#pragma unroll
                for (int bj = 0; bj < 2; ++bj) { const f32x4 v0 = acc[ai][bj][m][0], v1 = acc[ai][bj][m][1];
                    u32x4 w; w.x = cvt_pk_bf16(v0[0], v0[1]); w.y = cvt_pk_bf16(v0[2], v0[3]); w.z = cvt_pk_bf16(v1[0], v1[1]); w.w = cvt_pk_bf16(v1[2], v1[3]);
                    *(u32x4*)(rowp + bj * HALF) = w;
                    if (u.pn == 6) { float t[8] = {v0[0], v0[1], v0[2], v0[3], v1[0], v1[1], v1[2], v1[3]};
                        if (bj == 1) {
#pragma unroll
                            for (int e = 0; e < 8; ++e) t[e] = fsigmoid(t[e]); }
                        else if (wc < 2) {
#pragma unroll
                            for (int e = 0; e < 8; ++e) t[e] = ftanh(t[e]); }
                        u32x4 a; a.x = cvt_pk_bf16(t[0], t[1]); a.y = cvt_pk_bf16(t[2], t[3]); a.z = cvt_pk_bf16(t[4], t[5]); a.w = cvt_pk_bf16(t[6], t[7]);
                        *(u32x4*)(AUX + row * NAUX + ct0 + bj * HALF) = a; } } }
    }
};
struct EpiDec {
    static constexpr bool PERM = true, AFTER_DRAIN = false;
    bf16_t* O; const float* w0; const float* a0;
    __device__ __forceinline__ void operator()(const f32x4 (&acc)[2][2][4][2], const Unit& u, int wr, int wc, int fr, int fq) const {
        const int row0 = u.pm * BM + wr * 64 + fr; const int ct0 = wc * 32 + 8 * fq; const int col0 = u.pn * BM + ct0;
        const int kind = u.pn < 4 ? 0 : (u.pn < 8 ? 1 : 2);
        const float* bp = kind == 0 ? w0 + u.pn * 256 : a0 + (u.pn - 4) * 256;
#pragma unroll
        for (int bj = 0; bj < 2; ++bj) {
            const f32x4 b0 = kind < 2 ? *(const f32x4*)(bp + ct0 + bj * HALF) : (f32x4){0.f, 0.f, 0.f, 0.f}, b1 = kind < 2 ? *(const f32x4*)(bp + ct0 + bj * HALF + 4) : (f32x4){0.f, 0.f, 0.f, 0.f};
            const float s = kind == 0 ? -DECAY_SCALE : 1.0f;
#pragma unroll
            for (int ai = 0; ai < 2; ++ai)
#pragma unroll
                for (int m = 0; m < 4; ++m) { bf16_t* rowp = O + (size_t)(row0 + ai * HALF + m * 16) * NDEC + col0;
                    f32x4 v0 = acc[ai][bj][m][0] + b0, v1 = acc[ai][bj][m][1] + b1;
                    if (kind < 2) {
#pragma unroll
                        for (int e = 0; e < 4; ++e) { v0[e] = s * fsigmoid(v0[e]); v1[e] = s * fsigmoid(v1[e]); } }
                    u32x4 w; w.x = cvt_pk_bf16(v0[0], v0[1]); w.y = cvt_pk_bf16(v0[2], v0[3]); w.z = cvt_pk_bf16(v1[0], v1[1]); w.w = cvt_pk_bf16(v1[2], v1[3]);
                    *(u32x4*)(rowp + bj * HALF) = w; }
        }
    }
};
struct EpiLru {
    static constexpr bool PERM = false, AFTER_DRAIN = false;
    bf16_t* LRU; const bf16_t* XC; const float* gab; const float* gxb; const float* spt;
    __device__ __forceinline__ void operator()(const f32x4 (&acc)[2][2][4][2], const Unit& u, int wr, int wc, int fr, int fq) const {
        const int row0 = u.pm * BM + wr * 64 + fr; const int c0 = u.pn * 64 + wc * 16 + fq * 4;
#pragma unroll
        for (int d = 0; d < 2; ++d) {
            const f32x4 bga = *(const f32x4*)(gab + d * 512 + c0), bgx = *(const f32x4*)(gxb + d * 512 + c0), sp = *(const f32x4*)(spt + d * 512 + c0);
#pragma unroll
            for (int ai = 0; ai < 2; ++ai)
#pragma unroll
                for (int m = 0; m < 4; ++m) { const size_t row = (size_t)(row0 + ai * HALF + m * 16);
                    const v2u xw = *(const v2u*)(XC + row * 512 + c0); const float xc[4] = {bflo(xw.x), bfhi(xw.x), bflo(xw.y), bfhi(xw.y)};
                    float la[4], uu[4];
#pragma unroll
                    for (int e = 0; e < 4; ++e) { const float rg = fsigmoid(acc[ai][0][m][d][e] + bga[e]), ig = fsigmoid(acc[ai][1][m][d][e] + bgx[e]);
                        la[e] = sp[e] * rg; const float x2 = 2.0f * la[e];
                        const float em1 = x2 > -0.25f ? -x2 * (1.0f + x2 * (0.5f + x2 * (0.16666667f + x2 * (0.041666668f + x2 * (0.0083333338f + x2 * 0.0013888889f))))) : 1.0f - fexp(x2);
                        uu[e] = sqrtf(em1) * (ig * xc[e]); }
                    bf16_t* p = LRU + (row * 2 + d) * 1024 + c0;
                    v2u w1; w1.x = cvt_pk_bf16(la[0], la[1]); w1.y = cvt_pk_bf16(la[2], la[3]); *(v2u*)p = w1;
                    v2u w2; w2.x = cvt_pk_bf16(uu[0], uu[1]); w2.y = cvt_pk_bf16(uu[2], uu[3]); *(v2u*)(p + 512) = w2; }
        }
    }
};
struct EpiRes {
    static constexpr bool PERM = false, AFTER_DRAIN = false;
    const float* baseA; const float* baseB; float* out; const float* gate0;
    __device__ __forceinline__ void operator()(const f32x4 (&acc)[2][2][4][2], const Unit& u, int wr, int wc, int fr, int fq) const {
        const int row0 = u.pm * BM + wr * 64 + fr, col0 = u.pn * BM + wc * 32 + 4 * fq;
        const int bi = u.pm < 32 ? 0 : 1 + ((u.pm - 32) >> 3);
        const float* gp = gate0 + (size_t)bi * 6144 + col0;
        const float* bs = u.pm < 32 ? baseA : baseB - (size_t)NCTXROWS * D;
        f32x4 gv[2][2];
#pragma unroll
        for (int bj = 0; bj < 2; ++bj)
#pragma unroll
            for (int n = 0; n < 2; ++n) gv[bj][n] = *(const f32x4*)(gp + bj * HALF + n * 16);
#pragma unroll
        for (int ai = 0; ai < 2; ++ai)
#pragma unroll
            for (int m = 0; m < 4; ++m) { const size_t off = (size_t)(row0 + ai * HALF + m * 16) * D + col0;
#pragma unroll
                for (int bj = 0; bj < 2; ++bj)
#pragma unroll
                    for (int n = 0; n < 2; ++n) { const f32x4 b = *(const f32x4*)(bs + off + bj * HALF + n * 16); *(f32x4*)(out + off + bj * HALF + n * 16) = b + gv[bj][n] * acc[ai][bj][m][n]; } }
    }
};
template <int CTRL, bool BC> __device__ __forceinline__ float dpp_f(float oldv, float x) {
    return __builtin_bit_cast(float, __builtin_amdgcn_update_dpp(__builtin_bit_cast(int, oldv), __builtin_bit_cast(int, x), CTRL, 0xf, 0xf, BC));
}
struct EpiFfn {
    static constexpr bool PERM = true, AFTER_DRAIN = false;
    bf16_t* ACT; const float* cw; const float* cb; PG8_LAS float* xbuf;
    __device__ __forceinline__ void operator()(const f32x4 (&acc)[2][2][4][2], const Unit& u, int wr, int wc, int fr, int fq) const {
        const bool ctx = u.pm < 32;
        const int wid = wr * 4 + wc;
        if (ctx) {
#pragma unroll
            for (int ai = 0; ai < 2; ++ai)
#pragma unroll
                for (int bj = 0; bj < 2; ++bj)
#pragma unroll
                    for (int n = 0; n < 2; ++n) {
                        if (fr == 0)  *(PG8_LAS f32x4*)(xbuf + ((((wid * 2 + ai) * 2 + 0) * 4 + fq) * 4 + bj * 2 + n) * 4) = acc[ai][bj][0][n];
                        if (fr == 15) *(PG8_LAS f32x4*)(xbuf + ((((wid * 2 + ai) * 2 + 1) * 4 + fq) * 4 + bj * 2 + n) * 4) = acc[ai][bj][3][n];
                    }
            asm volatile("s_waitcnt lgkmcnt(0)" ::: "memory"); __builtin_amdgcn_s_barrier(); asm volatile("" ::: "memory");
        }
        const int row0 = u.pm * BM + wr * 64 + fr; const int ct0 = wc * 32 + 8 * fq;
#pragma unroll
        for (int n = 0; n < 2; ++n) {
            const int ca = u.pn * 128 + ct0 + 4 * n;
            f32x4 w0a = *(const f32x4*)(cw + ca), w1a = *(const f32x4*)(cw + 5632 + ca), w2a = *(const f32x4*)(cw + 2 * 5632 + ca), cba = *(const f32x4*)(cb + ca);
            f32x4 w0b = *(const f32x4*)(cw + 2816 + ca), w1b = *(const f32x4*)(cw + 5632 + 2816 + ca), w2b = *(const f32x4*)(cw + 2 * 5632 + 2816 + ca), cbb = *(const f32x4*)(cb + 2816 + ca);
#pragma unroll
            for (int ai = 0; ai < 2; ++ai) {
                const int blk = 2 * ai + wr;
                f32x4 pa = {0.f, 0.f, 0.f, 0.f}, pb = pa, na = pa, nb = pa;
                if (ctx && blk > 0) { const int pw = ((blk - 1) & 1) * 4 + wc, pai = (blk - 1) >> 1;
                    pa = *(const PG8_LAS f32x4*)(xbuf + ((((pw * 2 + pai) * 2 + 1) * 4 + fq) * 4 + 0 * 2 + n) * 4); pb = *(const PG8_LAS f32x4*)(xbuf + ((((pw * 2 + pai) * 2 + 1) * 4 + fq) * 4 + 1 * 2 + n) * 4); }
                if (ctx && blk < 3) { const int nw = ((blk + 1) & 1) * 4 + wc, nai = (blk + 1) >> 1;
                    na = *(const PG8_LAS f32x4*)(xbuf + ((((nw * 2 + nai) * 2 + 0) * 4 + fq) * 4 + 0 * 2 + n) * 4); nb = *(const PG8_LAS f32x4*)(xbuf + ((((nw * 2 + nai) * 2 + 0) * 4 + fq) * 4 + 1 * 2 + n) * 4); }
#pragma unroll
                for (int m = 0; m < 4; ++m) {
                    float o[4];
#pragma unroll
                    for (int e = 0; e < 4; ++e) {
                        const float xa = acc[ai][0][m][n][e], xb = acc[ai][1][m][n][e];
                        const float ta = m > 0 ? dpp_f<0x10F, true>(0.f, acc[ai][0][m > 0 ? m - 1 : 0][n][e]) : pa[e];
                        const float tb = m > 0 ? dpp_f<0x10F, true>(0.f, acc[ai][1][m > 0 ? m - 1 : 0][n][e]) : pb[e];
                        const float ba = m < 3 ? dpp_f<0x11F, true>(0.f, acc[ai][0][m < 3 ? m + 1 : 3][n][e]) : na[e];
                        const float bb = m < 3 ? dpp_f<0x11F, true>(0.f, acc[ai][1][m < 3 ? m + 1 : 3][n][e]) : nb[e];
                        const float upa = dpp_f<0x111, false>(ta, xa), upb = dpp_f<0x111, false>(tb, xb);
                        const float dna = dpp_f<0x101, false>(ba, xa), dnb = dpp_f<0x101, false>(bb, xb);
                        const float ua = cba[e] + w0a[e] * upa + w1a[e] * xa + w2a[e] * dna;
                        const float ub = cbb[e] + w0b[e] * upb + w1b[e] * xb + w2b[e] * dnb;
                        o[e] = gelu_tanh(ua) * ub;
                    }
                    v2u w; w.x = cvt_pk_bf16(o[0], o[1]); w.y = cvt_pk_bf16(o[2], o[3]);
                    *(v2u*)(ACT + (size_t)(row0 + ai * HALF + m * 16) * DFF + ca) = w;
                }
            }
        }
    }
};
}

template <class RowMap>
__device__ __forceinline__ void transpose_item(const float* W, int srcN, int k0, int n0, bf16* dst, int dstK, int kdst0, RowMap rm, LAS float* scr, int lane) {
#pragma unroll 8
    for (int i = 0; i < 32; ++i) { const int kk = 2 * i + (lane >> 5); scr[kk * 33 + (lane & 31)] = W[(size_t)(k0 + kk) * srcN + n0 + (lane & 31)]; }
    LDS_WAIT(); asm volatile("" ::: "memory");
    const int c = lane & 7;
#pragma unroll
    for (int j = 0; j < 4; ++j) { const int n = (lane >> 3) + 8 * j; const LAS float* s = scr + (8 * c) * 33 + n;
        v4u o; o.x = pk2(s[0 * 33], s[1 * 33]); o.y = pk2(s[2 * 33], s[3 * 33]); o.z = pk2(s[4 * 33], s[5 * 33]); o.w = pk2(s[6 * 33], s[7 * 33]);
        *(GAS v4u*)(dst + (size_t)rm(n) * dstK + kdst0 + 8 * c) = o; }
    LDS_WAIT(); asm volatile("" ::: "memory");
}
constexpr int IT_IN = 16 * 88, IT_OUT = 16 * 32, IT_UP = 16 * 176, IT_DOWN = 44 * 32, IT_AUX = 96, IT_LRU = 64, IT_LAYER = IT_IN + IT_OUT + IT_UP + IT_DOWN + IT_AUX + IT_LRU;
constexpr int ZR_LAYER = NDEC + NLRU;
constexpr int N_T0 = DEPTH * IT_LAYER, N_T1 = DEPTH * ZR_LAYER, N_T2 = DEPTH * 8 * 24;
__device__ __forceinline__ void p0_prologue(Frame& F) {
    LAS float* scr = (LAS float*)(F.lds + RING_OFF + F.wave * 16384);
    const int gw = F.vcu * NWAVES + F.wave, NGW = F.G * NWAVES; const int lane = F.lane;
    for (int t = gw; t < N_T2; t += NGW) {
        const int l = t / 192, ks = (t % 192) / 24, nb = t % 24;
        const float* W = F.in[I_WMOD] + ((size_t)l * 1024 + ks * 128) * 6144 + nb * 256 + lane * 4;
        f32x4 a0 = {0.f, 0.f, 0.f, 0.f}, a1 = a0, a2 = a0, a3 = a0, a4 = a0;
#pragma unroll 4
        for (int k = 0; k < 128; ++k) {
            const f32x4 w = *(const f32x4*)(W + (size_t)k * 6144); const int kk = ks * 128 + k;
            const float c0 = F.in[I_CCTX][kk], c1 = F.in[I_C][kk], c2 = F.in[I_C][1024 + kk], c3 = F.in[I_C][2048 + kk], c4 = F.in[I_C][3072 + kk];
            a0 += (c0 * fsigmoid(c0)) * w; a1 += (c1 * fsigmoid(c1)) * w; a2 += (c2 * fsigmoid(c2)) * w; a3 += (c3 * fsigmoid(c3)) * w; a4 += (c4 * fsigmoid(c4)) * w;
        }
        float* P = (float*)(F.ws + WS_MODP) + (((size_t)l * 8 + ks) * 5) * 6144 + nb * 256 + lane * 4;
        *(f32x4*)(P) = a0; *(f32x4*)(P + 6144) = a1; *(f32x4*)(P + 2 * 6144) = a2; *(f32x4*)(P + 3 * 6144) = a3; *(f32x4*)(P + 4 * 6144) = a4;
    }
    for (int it = gw; it < N_T0; it += NGW) {
        const int l = it / IT_LAYER; int r = it % IT_LAYER;
        if (r < IT_IN) { const int kb = r / 88, nb = r % 88; transpose_item(F.in[I_WIN] + (size_t)l * 1024 * PIN, PIN, 64 * kb, 32 * nb, wlayer(F, l, WL_IN), 1024, 64 * kb, [=](int n) { return 32 * nb + n; }, scr, lane); continue; } r -= IT_IN;
        if (r < IT_OUT) { const int kb = r / 32, nb = r % 32; transpose_item(F.in[I_WOUT] + (size_t)l * 1024 * 1024, 1024, 64 * kb, 32 * nb, wlayer(F, l, WL_OUT), 1024, 64 * kb, [=](int n) { return 32 * nb + n; }, scr, lane); continue; } r -= IT_OUT;
        if (r < IT_UP) { const int kb = r / 176, nb = r % 176; const int n0 = 32 * nb; const int nn = n0 < DFF ? n0 : n0 - DFF; const int rb = 256 * (nn / 128) + (n0 < DFF ? 0 : 128) + (nn % 128);
            transpose_item(F.in[I_WUP] + (size_t)l * 1024 * 5632, 5632, 64 * kb, n0, wlayer(F, l, WL_UP), 1024, 64 * kb, [=](int n) { return rb + n; }, scr, lane); continue; } r -= IT_UP;
        if (r < IT_DOWN) { const int kb = r / 32, nb = r % 32; transpose_item(F.in[I_WDOWN] + (size_t)l * DFF * 1024, 1024, 64 * kb, 32 * nb, wlayer(F, l, WL_DOWN), DFF, 64 * kb, [=](int n) { return 32 * nb + n; }, scr, lane); continue; } r -= IT_DOWN;
        if (r < IT_AUX) {
            if (r < 32) { const int d = r / 16, nb = r % 16; transpose_item(F.in[I_RW_WUP] + ((size_t)l * 2 + d) * 64 * 512, 512, 0, 32 * nb, wlayer(F, l, WL_AUX), NAUX, 0, [=](int n) { return d * 512 + 32 * nb + n; }, scr, lane); }
            else if (r < 64) { const int d = (r - 32) / 16, nb = r % 16; transpose_item(F.in[I_RW_AUP] + ((size_t)l * 2 + d) * 64 * 512, 512, 0, 32 * nb, wlayer(F, l, WL_AUX), NAUX, 64, [=](int n) { return 1024 + d * 512 + 32 * nb + n; }, scr, lane); }
            else { const int kb = (r - 64) / 16, nb = r % 16; transpose_item(F.in[I_RW_GUP] + (size_t)l * 128 * 512, 512, 64 * kb, 32 * nb, wlayer(F, l, WL_AUX), NAUX, 128 + 64 * kb, [=](int n) { return 2048 + 32 * nb + n; }, scr, lane); }
            continue; } r -= IT_AUX;
        { const int q = r / 16, h = (r % 16) / 2, nb = r % 2;
          const float* src = (q < 2 ? F.in[I_LRU_GAW] : F.in[I_LRU_GXW]) + (((size_t)l * 2 + (q & 1)) * 8 + h) * 4096;
          transpose_item(src, 64, 0, 32 * nb, wlayer(F, l, WL_LRU), 256, 64 * (h & 3), [=](int n) { const int j = 32 * nb + n; return 256 * h + 128 * (q >> 1) + 16 * (q & 1) + 32 * (j >> 4) + (j & 15); }, scr, lane); }
    }
    for (int t = gw; t < N_T1; t += NGW) {
        const int l = t / ZR_LAYER, r = t % ZR_LAYER; const int k = 4 * lane;
        if (r < NDEC) { const int lo = r < 1024 ? 0 : (r < 2048 ? 64 : 128), hi = r < 1024 ? 64 : (r < 2048 ? 128 : 256);
            if (k < lo || k >= hi) *(GAS v2u*)(wlayer(F, l, WL_AUX) + (size_t)r * NAUX + k) = (v2u){0u, 0u}; }
        else { const int rr = r - NDEC, h = rr >> 8; const int lo = 64 * (h & 3);
            if (k < lo || k >= lo + 64) *(GAS v2u*)(wlayer(F, l, WL_LRU) + (size_t)rr * 256 + k) = (v2u){0u, 0u}; }
    }
}
__device__ __forceinline__ void p1_modreduce(Frame& F) {
    const int gt = (F.vcu * NWAVES + F.wave) * 64 + F.lane, NT = F.G * NWAVES * 64;
    for (int i = gt; i < DEPTH * 5 * 6144; i += NT) { const int l = i / (5 * 6144), r = i % (5 * 6144), n = r % 6144, bi = r / 6144;
        float s = F.in[I_BMOD][l * 6144 + n];
#pragma unroll
        for (int ks = 0; ks < 8; ++ks) s += ((const float*)(F.ws + WS_MODP))[(((size_t)l * 8 + ks) * 5 + bi) * 6144 + n];
        ((float*)(F.ws + WS_MOD))[i] = s; }
    for (int i = gt; i < DEPTH * 1024; i += NT) { const float x = -F.in[I_LRU_LAM][i]; ((float*)(F.ws + WS_SPT))[i] = -8.0f * (fmaxf(x, 0.f) + log1pf(expf(-fabsf(x)))); }
}
__device__ __forceinline__ void modnorm_row(const float* xrow, bf16* orow, const float* g, const float* sc, const float* sh, int lane) {
    const GAS f32x4* xr = (const GAS f32x4*)xrow + lane;
    f32x4 v[4]; float s = 0.f;
#pragma unroll
    for (int j = 0; j < 4; ++j) { v[j] = xr[64 * j]; s += (v[j].x * v[j].x + v[j].y * v[j].y) + (v[j].z * v[j].z + v[j].w * v[j].w); }
    const float rstd = 1.0f / sqrtf(wave_sum(s) * (1.f / D) + 1e-6f);
    GAS unsigned long long* o8 = (GAS unsigned long long*)orow + lane;
#pragma unroll
    for (int j = 0; j < 4; ++j) { const int c = 4 * lane + 256 * j; const f32x4 gg = *(const f32x4*)(g + c), ss = *(const f32x4*)(sc + c), hh = *(const f32x4*)(sh + c);
        const f32x4 y = v[j] * rstd * gg * (ss + 1.0f) + hh;
        o8[64 * j] = (unsigned long long)pk2(y.x, y.y) | ((unsigned long long)pk2(y.z, y.w) << 32); }
}
__device__ __forceinline__ const float* xrow_in(const Frame& F, int r) { return r < NCTXROWS ? F.in[I_XP] + (size_t)r * D : F.in[I_XS] + (size_t)(r - NCTXROWS) * D; }
__device__ __forceinline__ void p_modnorm(Frame& F, int l, int which, bool from_input) {
    const int gw = F.vcu * NWAVES + F.wave, NGW = F.G * NWAVES;
    const float* g = F.in[which ? I_LN2G : I_LN1G] + l * D;
    for (int r = gw; r < M; r += NGW) { const float* mp = modp(F, l, row_bidx(r)) + (which ? 3072 : 0);
        modnorm_row(from_input ? xrow_in(F, r) : F.out + (size_t)r * D, (bf16*)(F.ws + WS_XN) + (size_t)r * D, g, mp + 1024, mp, F.lane); }
}
__device__ __forceinline__ void p_finalnorm(Frame& F) {
    const int gw = F.vcu * NWAVES + F.wave, NGW = F.G * NWAVES; const float* g = F.in[I_LNFG];
    for (int r = gw; r < M; r += NGW) { GAS f32x4* xr = (GAS f32x4*)(F.out + (size_t)r * D) + F.lane;
        f32x4 v[4]; float s = 0.f;
#pragma unroll
        for (int j = 0; j < 4; ++j) { v[j] = xr[64 * j]; s += (v[j].x * v[j].x + v[j].y * v[j].y) + (v[j].z * v[j].z + v[j].w * v[j].w); }
        const float rstd = 1.0f / sqrtf(wave_sum(s) * (1.f / D) + 1e-6f);
#pragma unroll
        for (int j = 0; j < 4; ++j) { const f32x4 gg = *(const f32x4*)(g + 4 * F.lane + 256 * j); xr[64 * j] = v[j] * rstd * gg; } }
}
__device__ __forceinline__ void p_lruconv(Frame& F, int l) {
    const int gt = (F.vcu * NWAVES + F.wave) * 64 + F.lane, NT = F.G * NWAVES * 64;
    const bf16* PROJ = (const bf16*)(F.ws + WS_PROJ); bf16* XC = (bf16*)(F.ws + WS_XN);
    const float* cw = F.in[I_LRU_CW] + l * 4 * 512; const float* cb = F.in[I_LRU_CB] + l * 512;
    for (int i = gt; i < M * 64; i += NT) { const int r = i >> 6, c = (i & 63) * 8;
        const int p = r < NCTXROWS ? (r & 255) : ((r - NCTXROWS) & 63), L = r < NCTXROWS ? 256 : 64;
        float a[8];
#pragma unroll
        for (int e = 0; e < 8; ++e) a[e] = cb[c + e];
#pragma unroll
        for (int j = 0; j < 4; ++j) { const int q = p + j - 2; if (q < 0 || q >= L) continue;
            const v4u w = *(const GAS v4u*)(PROJ + (size_t)(r + j - 2) * PIN + C_XB + c); const float* wj = cw + j * 512 + c;
            a[0] += bflo(w.x) * wj[0]; a[1] += bfhi(w.x) * wj[1]; a[2] += bflo(w.y) * wj[2]; a[3] += bfhi(w.y) * wj[3];
            a[4] += bflo(w.z) * wj[4]; a[5] += bfhi(w.z) * wj[5]; a[6] += bflo(w.w) * wj[6]; a[7] += bfhi(w.w) * wj[7]; }
        v4u o; o.x = pk2(a[0], a[1]); o.y = pk2(a[2], a[3]); o.z = pk2(a[4], a[5]); o.w = pk2(a[6], a[7]);
        *(GAS v4u*)(XC + (size_t)r * 512 + c) = o; }
}
__device__ __forceinline__ void rwkv_scan_naive(Frame& F, int l, int task, LAS float* scr) {
    const bool lat = task < 64; const int tt0 = lat ? task : task - 64; const int s = tt0 >> 4, d = (tt0 >> 3) & 1, h = tt0 & 7;
    const int T = lat ? DSEQ : SEQ; const int row0 = lat ? NCTXROWS + s * DSEQ : s * SEQ; const int lane = F.lane;
    const bf16* PROJ = (const bf16*)(F.ws + WS_PROJ); bf16* DEC = (bf16*)(F.ws + WS_DEC);
    float S[64];
    if (lat) { const float* sp = F.in[I_SRWKV] + ((((size_t)s * 4 + l) * 2 + d) * 8 + h) * 4096 + lane * 64;
#pragma unroll
        for (int j = 0; j < 64; j += 4) { const f32x4 v = *(const f32x4*)(sp + j); S[j] = v.x; S[j + 1] = v.y; S[j + 2] = v.z; S[j + 3] = v.w; } }
    else {
#pragma unroll
        for (int j = 0; j < 64; ++j) S[j] = 0.f; }
    const float kkw = F.in[I_RW_KK][l * 512 + h * 64 + lane], kaw = F.in[I_RW_KA][l * 512 + h * 64 + lane];
    for (int tt = 0; tt < T; ++tt) {
        const int t = d ? T - 1 - tt : tt; const size_t r = (size_t)(row0 + t);
        const float kj = bf2f(PROJ[r * PIN + C_K + h * 64 + lane]), rj = bf2f(PROJ[r * PIN + C_R + h * 64 + lane]), vi = bf2f(PROJ[r * PIN + C_V + h * 64 + lane]);
        const float lw = bf2f(DEC[r * NDEC + d * 512 + h * 64 + lane]), aj = bf2f(DEC[r * NDEC + 1024 + d * 512 + h * 64 + lane]);
        float kk = kj * kkw; const float nrm = wave_sum(kk * kk); kk *= 1.0f / sqrtf(nrm + 1e-12f);
        scr[lane] = kk; scr[64 + lane] = fexp(lw); scr[128 + lane] = kk * aj; scr[192 + lane] = kj * (1.0f + (aj - 1.0f) * kaw); scr[256 + lane] = rj;
        LDS_WAIT(); asm volatile("" ::: "memory");
        float sa0 = 0.f, sa1 = 0.f, sa2 = 0.f, sa3 = 0.f;
#pragma unroll
        for (int j = 0; j < 64; j += 4) { const f32x4 q = *(const LAS f32x4*)(scr + j); sa0 += S[j] * q.x; sa1 += S[j + 1] * q.y; sa2 += S[j + 2] * q.z; sa3 += S[j + 3] * q.w; }
        const float sa = (sa0 + sa1) + (sa2 + sa3);
        float y0 = 0.f, y1 = 0.f, y2 = 0.f, y3 = 0.f;
#pragma unroll
        for (int j = 0; j < 64; j += 4) { const f32x4 w = *(const LAS f32x4*)(scr + 64 + j), b = *(const LAS f32x4*)(scr + 128 + j), kd = *(const LAS f32x4*)(scr + 192 + j), rr = *(const LAS f32x4*)(scr + 256 + j);
            S[j] = S[j] * w.x - sa * b.x + vi * kd.x; S[j + 1] = S[j + 1] * w.y - sa * b.y + vi * kd.y; S[j + 2] = S[j + 2] * w.z - sa * b.z + vi * kd.z; S[j + 3] = S[j + 3] * w.w - sa * b.w + vi * kd.w;
            y0 += S[j] * rr.x; y1 += S[j + 1] * rr.y; y2 += S[j + 2] * rr.z; y3 += S[j + 3] * rr.w; }
        LDS_WAIT(); asm volatile("" ::: "memory");
        DEC[r * NDEC + d * 512 + h * 64 + lane] = (bf16)f2bf((y0 + y1) + (y2 + y3));
    }
    if (!lat) { float* op = F.out + O_SRWKV + ((((size_t)s * 4 + l) * 2 + d) * 8 + h) * 4096 + lane * 64;
#pragma unroll
        for (int j = 0; j < 64; j += 4) *(f32x4*)(op + j) = (f32x4){S[j], S[j + 1], S[j + 2], S[j + 3]}; }
}
__device__ __forceinline__ void lru_scan_naive(Frame& F, int l, int task) {
    const bool lat = task < 64; const int tt0 = lat ? task : task - 64; const int s = tt0 >> 4, d = (tt0 >> 3) & 1, cbk = tt0 & 7;
    const int T = lat ? DSEQ : SEQ; const int row0 = lat ? NCTXROWS + s * DSEQ : s * SEQ; const int c = cbk * 64 + F.lane;
    bf16* LRU = (bf16*)(F.ws + WS_LRU);
    float h = lat ? F.in[I_SLRU][(((size_t)s * 4 + l) * 2 + d) * 512 + c] : 0.f;
#pragma unroll 8
    for (int tt = 0; tt < T; ++tt) { const int t = d ? T - 1 - tt : tt; bf16* p = LRU + ((size_t)(row0 + t) * 2 + d) * 1024 + c;
        const float la = bf2f(p[0]), u = bf2f(p[512]); h = fexp(la) * h + u; p[512] = (bf16)f2bf(h); }
    if (!lat) F.out[O_SLRU + (((size_t)s * 4 + l) * 2 + d) * 512 + c] = h;
}
__device__ __forceinline__ void p_scan_naive(Frame& F, int l) {
    LAS float* scr = (LAS float*)(F.lds + RING_OFF + F.wave * 2048);
    const int gwt = F.wave * F.G + F.vcu, NGW = F.G * NWAVES;
    for (int t = gwt; t < 1152; t += NGW) {
        if (t < 64) rwkv_scan_naive(F, l, t, scr);
        else if (t < 128) lru_scan_naive(F, l, t - 64);
        else if (t < 640) rwkv_scan_naive(F, l, t - 128 + 64, scr);
        else lru_scan_naive(F, l, t - 640 + 64);
    }
}
__device__ __forceinline__ void ld8(const bf16* p, float (&o)[8]) { const v4u w = *(const GAS v4u*)p; o[0] = bflo(w.x); o[1] = bfhi(w.x); o[2] = bflo(w.y); o[3] = bfhi(w.y); o[4] = bflo(w.z); o[5] = bfhi(w.z); o[6] = bflo(w.w); o[7] = bfhi(w.w); }
__device__ __forceinline__ void ld8f(const float* p, float (&o)[8]) { const f32x4 a = *(const f32x4*)p, b = *(const f32x4*)(p + 4); o[0] = a.x; o[1] = a.y; o[2] = a.z; o[3] = a.w; o[4] = b.x; o[5] = b.y; o[6] = b.z; o[7] = b.w; }
__device__ __forceinline__ float sum8lanes(float v) { v += __shfl_xor(v, 1); v += __shfl_xor(v, 2); v += __shfl_xor(v, 4); return v; }
__device__ __forceinline__ void p_combine(Frame& F, int l) {
    const int gw = F.vcu * NWAVES + F.wave, NGW = F.G * NWAVES; const int lane = F.lane; const int c = lane * 8;
    const bf16* PROJ = (const bf16*)(F.ws + WS_PROJ); const bf16* DEC = (const bf16*)(F.ws + WS_DEC); const bf16* LRU = (const bf16*)(F.ws + WS_LRU); bf16* CAT = (bf16*)(F.ws + WS_XN);
    float lg[8], lb[8], ka[8], rk[8];
    ld8f(F.in[I_RW_LNXG] + l * 512 + c, lg); ld8f(F.in[I_RW_LNXB] + l * 512 + c, lb); ld8f(F.in[I_RW_KA] + l * 512 + c, ka); ld8f(F.in[I_RW_RK] + l * 512 + c, rk);
    for (int r = gw; r < M; r += NGW) {
        const bf16* pr = PROJ + (size_t)r * PIN; const bf16* dr = DEC + (size_t)r * NDEC; const bf16* lr = LRU + (size_t)r * 2048;
        float y0[8], y1[8], a0[8], a1[8], gg[8], rr[8], kk[8], vv[8], o[8];
        ld8(dr + c, y0); ld8(dr + 512 + c, y1); ld8(dr + 1024 + c, a0); ld8(dr + 1536 + c, a1); ld8(dr + 2048 + c, gg);
        ld8(pr + C_R + c, rr); ld8(pr + C_K + c, kk); ld8(pr + C_V + c, vv);
        float s = 0.f, bs = 0.f;
#pragma unroll
        for (int e = 0; e < 8; ++e) { o[e] = y0[e] + y1[e]; s += o[e]; bs += rr[e] * kk[e] * (2.0f + (a0[e] + a1[e] - 2.0f) * ka[e]) * rk[e]; }
        const float mu = sum8lanes(s) * (1.f / 64.f); const float bonus = sum8lanes(bs); float q = 0.f;
#pragma unroll
        for (int e = 0; e < 8; ++e) { o[e] -= mu; q += o[e] * o[e]; }
        const float rstd = 1.0f / sqrtf(sum8lanes(q) * (1.f / 64.f) + 64e-5f);
        float ya[8];
#pragma unroll
        for (int e = 0; e < 8; ++e) ya[e] = (o[e] * rstd * lg[e] + lb[e] + bonus * vv[e]) * gg[e];
        v4u w; w.x = pk2(ya[0], ya[1]); w.y = pk2(ya[2], ya[3]); w.z = pk2(ya[4], ya[5]); w.w = pk2(ya[6], ya[7]);
        *(GAS v4u*)(CAT + (size_t)r * D + c) = w;
        float h0[8], h1[8], gb[8];
        ld8(lr + 512 + c, h0); ld8(lr + 1024 + 512 + c, h1); ld8(pr + C_GB + c, gb);
#pragma unroll
        for (int e = 0; e < 8; ++e) ya[e] = bf2f((bf16)f2bf(h0[e] + h1[e])) * gelu_tanh(gb[e]);
        w.x = pk2(ya[0], ya[1]); w.y = pk2(ya[2], ya[3]); w.z = pk2(ya[4], ya[5]); w.w = pk2(ya[6], ya[7]);
        *(GAS v4u*)(CAT + (size_t)r * D + 512 + c) = w;
    }
}

constexpr int PH_PER_LAYER = 10, PH_PRO = 3, N_PHASES = PH_PRO + DEPTH * PH_PER_LAYER;
__global__ void __launch_bounds__(NWAVES * 64, 2) mk_fwd(Args args) {
    extern __shared__ __attribute__((aligned(16))) unsigned char lds[];
    Frame F;
    F.lds = (LAS unsigned char*)lds;
    F.tid = threadIdx.x; F.lane = F.tid & 63; F.wave = __builtin_amdgcn_readfirstlane(F.tid >> 6);
    F.G = gridDim.x; { const int bx = blockIdx.x; F.vcu = (F.G % 8 == 0) ? (bx % 8) * (F.G / 8) + bx / 8 : bx; }
    F.in = args.in; F.out = args.out; F.ws = args.ws;
    volatile LAS unsigned* MISC = (volatile LAS unsigned*)(F.lds + MISC_OFF);
    for (int u = F.tid; u < (LDS_BYTES - LDSCTL_OFF) / 4; u += NWAVES * 64) ((LAS unsigned*)(F.lds + LDSCTL_OFF))[u] = 0u;
    __syncthreads();
    const int lo = args.ph_lo, hi = args.ph_hi;
    XcdBarrier bar; bar.bar = (unsigned*)(F.ws + WS_CTL) + CW_BAR; bar.x = 0; bar.st = nullptr;
    if (hi - lo > 1) bar = xcd_barrier_post((unsigned*)(F.ws + WS_CTL) + CW_BAR, MISC + 8);
    bf16* XN = (bf16*)(F.ws + WS_XN); bf16* PROJ = (bf16*)(F.ws + WS_PROJ); bf16* DEC = (bf16*)(F.ws + WS_DEC); bf16* LRU = (bf16*)(F.ws + WS_LRU); bf16* AUX = LRU; bf16* ACT = PROJ; bf16* XC = XN;
    for (int ph = lo; ph < hi; ++ph) {
        { int t_ = threadIdx.x; asm volatile("" : "+v"(t_)); F.tid = t_; F.lane = t_ & 63; F.wave = __builtin_amdgcn_readfirstlane(t_ >> 6); }
        if (ph == 1000) {
            const bf16* src = (const bf16*)(F.ws + (MK_DBG_BUF == 0 ? WS_PROJ : MK_DBG_BUF == 1 ? WS_DEC : MK_DBG_BUF == 2 ? WS_LRU : WS_XN));
            const size_t gt = (size_t)(F.vcu * NWAVES + F.wave) * 64 + F.lane, NT = (size_t)F.G * NWAVES * 64;
            for (size_t i = gt; i < (size_t)16777216; i += NT) F.out[i] = bf2f(src[i]);
        } else
        if (ph == 0) { if (MK_EN & 1) p0_prologue(F); }
        else if (ph == 1) { if (MK_EN & 2) p1_modreduce(F); }
        else if (ph == 2) { if (MK_EN & 4) p_modnorm(F, 0, 0, true); }
        else {
            const int l = (ph - PH_PRO) / PH_PER_LAYER, s = (ph - PH_PRO) % PH_PER_LAYER;
            if (s == 0) { if (MK_EN & 8) {
                pg8::Gemm g{XN, wlayer(F, l, WL_IN), M, PIN, D, D, 0, 0}; pg8::StaticOrder S; S.init(M, PIN, F.G, (int)blockIdx.x);
                pg8::EpiProj E{PROJ, AUX};
                pg8::gemm_phase<pg8::EpiProj, pg8::StaticOrder, true, true>(F.lds + RING_OFF, g, S, E);
            } } else if (s == 1) { if (MK_EN & 16) {
                { pg8::Gemm g{AUX, wlayer(F, l, WL_AUX), M, NDEC, NAUX, NAUX, 0, 0}; pg8::StaticOrder S; S.init(M, NDEC, F.G, (int)blockIdx.x);
                  pg8::EpiDec E{DEC, F.in[I_RW_W0] + l * 1024, F.in[I_RW_A0] + l * 1024};
                  pg8::gemm_phase<pg8::EpiDec, pg8::StaticOrder, true, true>(F.lds + RING_OFF, g, S, E); }
                p_lruconv(F, l);
            } } else if (s == 2) { if (MK_EN & 32) {
                pg8::Gemm g{XC, wlayer(F, l, WL_LRU), M, NLRU, 256, 512, 256, 2}; pg8::StaticOrder S; S.init(M, NLRU, F.G, (int)blockIdx.x);
                pg8::EpiLru E{LRU, XC, F.in[I_LRU_GAB] + l * 1024, F.in[I_LRU_GXB] + l * 1024, (const float*)(F.ws + WS_SPT) + l * 1024};
                pg8::gemm_phase<pg8::EpiLru, pg8::StaticOrder, true, true>(F.lds + RING_OFF, g, S, E);
            } } else if (s == 3) { if (MK_EN & 64) p_scan_naive(F, l); }
            else if (s == 4) { if (MK_EN & 128) p_combine(F, l); }
            else if (s == 5) { if (MK_EN & 256) {
                pg8::Gemm g{XN, wlayer(F, l, WL_OUT), M, D, D, D, 0, 0}; pg8::StaticOrder S; S.init(M, D, F.G, (int)blockIdx.x);
                pg8::EpiRes E{l == 0 ? F.in[I_XP] : F.out, l == 0 ? F.in[I_XS] : F.out + (size_t)NCTXROWS * D, F.out, modp(F, l, 0) + 2048};
                pg8::gemm_phase<pg8::EpiRes, pg8::StaticOrder, true, true>(F.lds + RING_OFF, g, S, E);
            } } else if (s == 6) { if (MK_EN & 512) p_modnorm(F, l, 1, false); }
            else if (s == 7) { if (MK_EN & 1024) {
                pg8::Gemm g{XN, wlayer(F, l, WL_UP), M, 2 * DFF, D, D, 0, 0}; pg8::StaticOrder S; S.init(M, 2 * DFF, F.G, (int)blockIdx.x);
                pg8::EpiFfn E{ACT, F.in[I_FCW] + (size_t)l * 3 * 5632, F.in[I_FCB] + (size_t)l * 5632, (PG8_LAS float*)(F.lds + XBUF_OFF)};
                pg8::gemm_phase<pg8::EpiFfn, pg8::StaticOrder, true, true>(F.lds + RING_OFF, g, S, E);
            } } else if (s == 8) { if (MK_EN & 2048) {
                pg8::Gemm g{ACT, wlayer(F, l, WL_DOWN), M, D, DFF, DFF, 0, 0}; pg8::StaticOrder S; S.init(M, D, F.G, (int)blockIdx.x);
                pg8::EpiRes E{F.out, F.out + (size_t)NCTXROWS * D, F.out, modp(F, l, 0) + 5120};
                pg8::gemm_phase<pg8::EpiRes, pg8::StaticOrder, true, true>(F.lds + RING_OFF, g, S, E);
            } } else { if (MK_EN & 4096) {
                if (l + 1 < DEPTH) p_modnorm(F, l + 1, 0, false); else p_finalnorm(F);
            } }
        }
        if (ph + 1 < hi) xcd_barrier(bar);
    }
}

extern "C" void kernel_launch(void* const* d_in, const int* in_sizes, int n_in, void* d_out, int out_size, void* d_ws, size_t ws_size, hipStream_t stream) {
    static int grid = 0;
    if (grid == 0) {
        if (n_in != N_IN || (size_t)out_size != OUT_TOTAL || ws_size < WS_END) { fprintf(stderr, "kernel_launch: unexpected shapes: n_in %d out %d ws %zu\n", n_in, out_size, ws_size); grid = -1; return; }
        int dev = 0, cus = 0;
        if (hipGetDevice(&dev) != hipSuccess || hipDeviceGetAttribute(&cus, hipDeviceAttributeMultiprocessorCount, dev) != hipSuccess) { grid = -1; return; }
        if (hipFuncSetAttribute((const void*)mk_fwd, hipFuncAttributeMaxDynamicSharedMemorySize, LDS_BYTES) != hipSuccess) { grid = -1; return; }
        (void)hipGetLastError();
        grid = cus;
    }
    if (grid < 0) return;
    (void)hipMemsetAsync((char*)d_ws + WS_CTL, 0, CTL_ZERO_BYTES, stream);
    Args a{};
    for (int i = 0; i < N_IN; ++i) a.in[i] = (const float*)d_in[i];
    a.out = (float*)d_out; a.ws = (unsigned char*)d_ws;
#if MK_ONE_LAUNCH
    a.ph_lo = 0; a.ph_hi = N_PHASES;
    hipLaunchKernelGGL(mk_fwd, dim3(grid), dim3(NWAVES * 64), LDS_BYTES, stream, a);
#else
    const int nph = MK_DBG_STOP ? MK_DBG_STOP : N_PHASES;
    for (int ph = 0; ph < nph; ++ph) { a.ph_lo = ph; a.ph_hi = ph + 1; hipLaunchKernelGGL(mk_fwd, dim3(grid), dim3(NWAVES * 64), LDS_BYTES, stream, a); }
    if (MK_DBG_STOP) { a.ph_lo = 1000; a.ph_hi = 1001; hipLaunchKernelGGL(mk_fwd, dim3(grid), dim3(NWAVES * 64), LDS_BYTES, stream, a); }
#endif
}
```

```cpp
#include <hip/hip_runtime.h>
#include <cstdio>
#include <cstdint>
#define MK_ONE_LAUNCH 1
namespace pg8 {
#define PG8_LAS __attribute__((address_space(3)))
typedef unsigned short bf16_t;
typedef short bf16x8 __attribute__((ext_vector_type(8)));
typedef float f32x4 __attribute__((ext_vector_type(4)));
typedef unsigned u32x4 __attribute__((ext_vector_type(4)));
constexpr int BM = 256, BK = 64, HALF = 128, HTB = HALF * BK * 2  , STAGE_BYTES = 8 * HTB, NXCD = 8, WGM = 8;

__host__ __device__ __forceinline__ int lds_byte(int r, int c) { const int st = (r >> 4) * 2 + (c >> 5), rr = r & 15, cc = c & 31, ob = rr * 64 + cc * 2; return st * 1024 + (ob ^ (((ob >> 9) & 1) << 5)); }
__host__ __device__ __forceinline__ void stage_rc(int b, int& R, int& C) { const int st = b / 1024, sb = b % 1024, swz = sb ^ (((sb >> 9) & 1) << 5); R = (st >> 1) * 16 + swz / 64; C = (st & 1) * 32 + (swz % 64) / 2; }
__host__ __device__ __forceinline__ int perm32(int rho) { const int n = rho >> 4, i = rho & 15; return 8 * (i >> 2) + 4 * n + (i & 3); }

struct Unit { int pm, pn; };
struct Gemm { const bf16_t* A; const bf16_t* Bt; int M, N, K; int lda; int apn; int apsh; };

struct StaticOrder {
    int nM, nN, nwg, G, c;
    __host__ __device__ void init(int M, int N, int G_, int c_) { nM = M / BM; nN = N / BM; nwg = nM * nN; G = G_; c = c_; }
    __host__ __device__ bool next(int i, Unit& u) const {
        const long L = (long)i * G + c; if (L >= nwg) return false;
        int wgid = (int)L; { const int q = nwg / NXCD, r = nwg % NXCD, xcd = wgid % NXCD, off = wgid / NXCD; wgid = (xcd < r ? xcd * (q + 1) : r * (q + 1) + (xcd - r) * q) + off; }
        const int nig = WGM * nN, gid = wgid / nig, fm = gid * WGM, gsz = (nM - fm) < WGM ? (nM - fm) : WGM;
        u.pm = fm + ((wgid % nig) % gsz); u.pn = (wgid % nig) / gsz; return true;
    }
    __device__ __forceinline__ void a_ready(const Unit&) const {}
    __device__ __forceinline__ void done(const Unit&) const {}
};

typedef __bf16 bf16x2_hw __attribute__((ext_vector_type(2)));
typedef float f32x2_cv __attribute__((ext_vector_type(2)));
__device__ __forceinline__ unsigned cvt_pk_bf16(float lo, float hi) { const f32x2_cv v = {lo, hi}; return __builtin_bit_cast(unsigned, __builtin_convertvector(v, bf16x2_hw)); }
typedef float f32x2 __attribute__((ext_vector_type(2)));
__device__ __forceinline__ f32x2 gelu_pk(f32x2 v) {
    const f32x2 av = __builtin_elementwise_abs(v), d = av * 0.2316418882f + 1.0f;
    f32x2 t; t.x = __builtin_amdgcn_rcpf(d.x); t.y = __builtin_amdgcn_rcpf(d.y);
    f32x2 q = t * 0.5307027145f + (-0.7265760135f); q = q * t + 0.7107068705f; q = q * t + (-0.142248368f); q = q * t + 0.127414796f; q = q * t;
    const f32x2 s = (v * v) * (-0.72134752044f);
    f32x2 e; e.x = __builtin_amdgcn_exp2f(s.x); e.y = __builtin_amdgcn_exp2f(s.y);
    const f32x2 m = v * (q * e), r = v - m;
    f32x2 o; o.x = v.x < 0.f ? m.x : r.x; o.y = v.y < 0.f ? m.y : r.y; return o;
}

template <int ACT  > struct EpiBf16 {
    static constexpr bool PERM = true, AFTER_DRAIN = false; static_assert(ACT == 0 || ACT == 1, "EpiBf16: ACT is 0 (none) or 1 (gelu_pk)");
    bf16_t* O; int ldc; const float* bias; int split_cols; size_t split_stride; float scale0;
    __device__ __forceinline__ void operator()(const f32x4 (&acc)[2][2][4][2], const Unit& u, int wr, int wc, int fr, int fq) const {
        const int row0 = u.pm * BM + wr * 64 + fr; int colt = u.pn * BM; bf16_t* base = O;
        float sc = 1.f; if (split_cols) { const int t = colt / split_cols; base += (size_t)t * split_stride; colt -= t * split_cols; if (t == 0) sc = scale0; }
        const int col0 = colt + wc * 32 + 8 * fq, bcol0 = u.pn * BM + wc * 32 + 8 * fq;
        f32x4 bv[2][2];
#pragma unroll
        for (int bj = 0; bj < 2; ++bj)
#pragma unroll
            for (int n = 0; n < 2; ++n) bv[bj][n] = bias ? *(const f32x4*)(bias + bcol0 + bj * HALF + 4 * n) : (f32x4){0.f, 0.f, 0.f, 0.f};
#pragma unroll
        for (int ai = 0; ai < 2; ++ai)
#pragma unroll
            for (int m = 0; m < 4; ++m) { bf16_t* rowp = base + (size_t)(row0 + ai * HALF + m * 16) * ldc + col0;
#pragma unroll
                for (int bj = 0; bj < 2; ++bj) { f32x4 v0 = acc[ai][bj][m][0] + bv[bj][0], v1 = acc[ai][bj][m][1] + bv[bj][1];
                    if (ACT == 1) { f32x2 a = gelu_pk((f32x2){v0[0], v0[1]}), b = gelu_pk((f32x2){v0[2], v0[3]}), c = gelu_pk((f32x2){v1[0], v1[1]}), d = gelu_pk((f32x2){v1[2], v1[3]});
                        v0 = (f32x4){a.x, a.y, b.x, b.y}; v1 = (f32x4){c.x, c.y, d.x, d.y}; }
                    v0 = v0 * sc; v1 = v1 * sc; u32x4 w; w.x = cvt_pk_bf16(v0[0], v0[1]); w.y = cvt_pk_bf16(v0[2], v0[3]); w.z = cvt_pk_bf16(v1[0], v1[1]); w.w = cvt_pk_bf16(v1[2], v1[3]);
                    *(u32x4*)(rowp + bj * HALF) = w; } }
    }
};

template <class Epi, class Sched, bool ALIGN_EPI = false, bool SP2 = false>
__device__ __forceinline__ void gemm_phase(PG8_LAS unsigned char* lds, const Gemm g, const Sched& S, const Epi& E) {
    int tid_ = threadIdx.x; asm volatile("" : "+v"(tid_));
    const int tid = tid_, wid = __builtin_amdgcn_readfirstlane(tid >> 6), lane = tid & 63, wr = wid >> 2, wc = wid & 3, fr = lane & 15, fq = lane >> 4;
    int K_ = g.K; asm volatile("" : "+s"(K_));
    const int K = K_, nt = K / BK;
    unsigned voffA[2], voffB[2];
#pragma unroll
    for (int i = 0; i < 2; ++i) { int R, C; stage_rc(tid * 16 + i * 8192, R, C); const int Rb = Epi::PERM ? ((R & ~31) + perm32(R & 31)) : R;
        voffA[i] = (unsigned)(R * g.lda + C) * 2u; voffB[i] = (unsigned)(Rb * K + C) * 2u; }
    const size_t kstep = (size_t)(BK * 2);
    const size_t hstepA = (size_t)HALF * g.lda * 2, hstepB = (size_t)HALF * K * 2;
    const size_t tstepA = 2 * hstepA, tstepB = 2 * hstepB, apnb = (size_t)g.apn * 2;
    const unsigned ldsw = (unsigned)wid * 1024u;
    const int aoff = lds_byte(wr * 64 + fr, fq * 8), boff = lds_byte(wc * 32 + fr, fq * 8);
#define PG8_SA(b, h) (((b) * 2 + (h)) * HTB)
#define PG8_SB(b, h) ((4 + (b) * 2 + (h)) * HTB)
#define PG8_STAGE(bufoff, gbase, voff) do { _Pragma("unroll") for (int _i = 0; _i < 2; ++_i) \
        __builtin_amdgcn_global_load_lds((const unsigned*)((const char*)(gbase) + (voff)[_i]), (PG8_LAS unsigned*)(lds + (bufoff) + ldsw + _i * 8192), 16, 0, 0); } while (0)
#define PG8_LDA(dst, b, h) do { _Pragma("unroll") for (int m = 0; m < 4; ++m) _Pragma("unroll") for (int k = 0; k < 2; ++k) dst[m][k] = *(const PG8_LAS bf16x8*)(lds + PG8_SA(b, h) + aoff + m * 2048 + k * 1024); } while (0)
#define PG8_LDB(dst, b, h) do { _Pragma("unroll") for (int n = 0; n < 2; ++n) _Pragma("unroll") for (int k = 0; k < 2; ++k) dst[n][k] = *(const PG8_LAS bf16x8*)(lds + PG8_SB(b, h) + boff + n * 2048 + k * 1024); } while (0)
#define PG8_MMA(ai, bj, At, Bt) do { __builtin_amdgcn_s_setprio(1); _Pragma("unroll") for (int m = 0; m < 4; ++m) _Pragma("unroll") for (int n = 0; n < 2; ++n) _Pragma("unroll") for (int k = 0; k < 2; ++k) \
        acc[ai][bj][m][n] = __builtin_amdgcn_mfma_f32_16x16x32_bf16(Bt[n][k], At[m][k], acc[ai][bj][m][n], 0, 0, 0); __builtin_amdgcn_s_setprio(0); } while (0)
#define PG8_WAIT_V(n) asm volatile("s_waitcnt vmcnt(" #n ")" ::: "memory")
#define PG8_WAIT_L(n) asm volatile("s_waitcnt lgkmcnt(" #n ")" ::: "memory")
#define PG8_BAR __builtin_amdgcn_s_barrier()
#define PG8_SCHED __builtin_amdgcn_sched_barrier(0)
    Unit cur, nxt; int ui = 0;
    if (!S.next(0, cur)) return;
    f32x4 acc[2][2][4][2];
#pragma unroll
    for (int a = 0; a < 2; ++a)
#pragma unroll
        for (int b = 0; b < 2; ++b)
#pragma unroll
            for (int m = 0; m < 4; ++m)
#pragma unroll
                for (int n = 0; n < 2; ++n) acc[a][b][m][n] = (f32x4){0.f, 0.f, 0.f, 0.f};
    bf16x8 At[4][2], B0[2][2], B1[2][2];
    const char* cA = (const char*)g.A + (size_t)cur.pm * tstepA + (size_t)(cur.pn >> g.apsh) * apnb; const char* cB = (const char*)g.Bt + (size_t)cur.pn * tstepB;
    S.a_ready(cur);
    if constexpr (SP2) {
        PG8_STAGE(PG8_SB(0, 0), cB, voffB); PG8_STAGE(PG8_SB(0, 1), cB + hstepB, voffB); PG8_STAGE(PG8_SA(0, 0), cA, voffA); PG8_STAGE(PG8_SA(0, 1), cA + hstepA, voffA);
        if (wr == 1) PG8_BAR;
        PG8_WAIT_V(2); PG8_BAR;
        PG8_STAGE(PG8_SB(1, 0), cB + kstep, voffB); PG8_STAGE(PG8_SA(1, 0), cA + kstep, voffA); PG8_STAGE(PG8_SB(1, 1), cB + hstepB + kstep, voffB);
        PG8_WAIT_V(6); PG8_BAR;
    } else {
        PG8_STAGE(PG8_SB(0, 0), cB, voffB); PG8_STAGE(PG8_SA(0, 0), cA, voffA); PG8_STAGE(PG8_SB(0, 1), cB + hstepB, voffB); PG8_STAGE(PG8_SA(0, 1), cA + hstepA, voffA);
        if (wr == 1) PG8_BAR;
        PG8_WAIT_V(4); PG8_BAR;
        PG8_STAGE(PG8_SB(1, 0), cB + kstep, voffB); PG8_STAGE(PG8_SA(1, 0), cA + kstep, voffA); PG8_STAGE(PG8_SB(1, 1), cB + hstepB + kstep, voffB);
        PG8_WAIT_V(6); PG8_BAR;
    }
    for (;;) {
        const bool has_next = S.next(ui + 1, nxt);
        const char* nA = has_next ? (const char*)g.A + (size_t)nxt.pm * tstepA + (size_t)(nxt.pn >> g.apsh) * apnb : cA; const char* nB = has_next ? (const char*)g.Bt + (size_t)nxt.pn * tstepB : cB;
        for (int t = 0; t < nt; t += 2) {
            const bool last = (t == nt - 2);
            const char* a1 = cA + (size_t)(t + 1) * kstep;
            const char* a2 = last ? nA : cA + (size_t)(t + 2) * kstep; const char* b2 = last ? nB : cB + (size_t)(t + 2) * kstep;
            const char* a3 = a2 + kstep; const char* b3 = b2 + kstep;
            if (last && has_next) S.a_ready(nxt);
            if constexpr (SP2) {
            PG8_LDB(B0, 0, 0); PG8_LDB(B1, 0, 1); PG8_SCHED; PG8_LDA(At, 0, 0); PG8_STAGE(PG8_SA(1, 1), a1 + hstepA, voffA);
            PG8_WAIT_V(8); PG8_WAIT_L(0); PG8_BAR; PG8_MMA(0, 0, At, B0); PG8_MMA(0, 1, At, B1); PG8_BAR; PG8_SCHED;
            PG8_LDA(At, 0, 1); PG8_STAGE(PG8_SB(0, 0), b2, voffB); PG8_STAGE(PG8_SB(0, 1), b2 + hstepB, voffB); PG8_STAGE(PG8_SA(0, 0), a2, voffA);
            PG8_WAIT_V(8); PG8_WAIT_L(0); PG8_BAR; PG8_MMA(1, 0, At, B0); PG8_MMA(1, 1, At, B1); PG8_BAR; PG8_SCHED;
            PG8_LDB(B0, 1, 0); PG8_LDB(B1, 1, 1); PG8_SCHED; PG8_LDA(At, 1, 0); PG8_STAGE(PG8_SA(0, 1), a2 + hstepA, voffA);
            PG8_WAIT_V(8); PG8_WAIT_L(0); PG8_BAR; PG8_MMA(0, 0, At, B0); PG8_MMA(0, 1, At, B1); PG8_BAR; PG8_SCHED;
            PG8_LDA(At, 1, 1); PG8_STAGE(PG8_SB(1, 0), b3, voffB); PG8_STAGE(PG8_SB(1, 1), b3 + hstepB, voffB); PG8_STAGE(PG8_SA(1, 0), a3, voffA);
            PG8_WAIT_V(8); PG8_WAIT_L(0); PG8_BAR; PG8_MMA(1, 0, At, B0); PG8_MMA(1, 1, At, B1); PG8_BAR; PG8_SCHED;
            } else {
            PG8_LDB(B0, 0, 0); PG8_SCHED; PG8_LDA(At, 0, 0); PG8_STAGE(PG8_SA(1, 1), a1 + hstepA, voffA);
            PG8_WAIT_L(8); PG8_BAR; PG8_WAIT_L(0); PG8_MMA(0, 0, At, B0); PG8_BAR; PG8_SCHED;
            PG8_LDB(B1, 0, 1); PG8_STAGE(PG8_SB(0, 0), b2, voffB);
            PG8_BAR; PG8_WAIT_L(0); PG8_MMA(0, 1, At, B1); PG8_BAR;
            PG8_LDA(At, 0, 1); PG8_STAGE(PG8_SA(0, 0), a2, voffA);
            PG8_BAR; PG8_WAIT_L(0); PG8_MMA(1, 0, At, B0); PG8_BAR; PG8_SCHED;
            PG8_STAGE(PG8_SB(0, 1), b2 + hstepB, voffB);
            PG8_WAIT_V(6); PG8_BAR; PG8_MMA(1, 1, At, B1); PG8_BAR;
            PG8_LDB(B0, 1, 0); PG8_SCHED; PG8_LDA(At, 1, 0); PG8_STAGE(PG8_SA(0, 1), a2 + hstepA, voffA);
            PG8_WAIT_L(8); PG8_BAR; PG8_WAIT_L(0); PG8_MMA(0, 0, At, B0); PG8_BAR; PG8_SCHED;
            PG8_LDB(B1, 1, 1); PG8_STAGE(PG8_SB(1, 0), b3, voffB);
            PG8_BAR; PG8_WAIT_L(0); PG8_MMA(0, 1, At, B1); PG8_BAR;
            PG8_LDA(At, 1, 1); PG8_STAGE(PG8_SA(1, 0), a3, voffA);
            PG8_BAR; PG8_WAIT_L(0); PG8_MMA(1, 0, At, B0); PG8_BAR; PG8_SCHED;
            PG8_STAGE(PG8_SB(1, 1), b3 + hstepB, voffB);
            PG8_WAIT_V(6); PG8_BAR; PG8_MMA(1, 1, At, B1); PG8_BAR;
            }
        }
        if constexpr (ALIGN_EPI) { if (wr == 0) PG8_BAR; }
        if constexpr (!Epi::AFTER_DRAIN) { E(acc, cur, wr, wc, fr, fq); S.done(cur); }
        if (!has_next) break;
#pragma unroll
        for (int a = 0; a < 2; ++a)
#pragma unroll
            for (int b = 0; b < 2; ++b)
#pragma unroll
                for (int m = 0; m < 4; ++m)
#pragma unroll
                    for (int n = 0; n < 2; ++n) acc[a][b][m][n] = (f32x4){0.f, 0.f, 0.f, 0.f};
        cur = nxt; cA = nA; cB = nB; ++ui;
        if constexpr (ALIGN_EPI) { if (wr == 1) PG8_BAR; }
    }
    PG8_WAIT_V(0);
    if constexpr (!ALIGN_EPI) { if (wr == 0) PG8_BAR; }
    PG8_BAR;
    if constexpr (Epi::AFTER_DRAIN) { E.fused(acc, cur, wr, wc, fr, fq, lds, wid, lane); S.done(cur); }
#undef PG8_SA
#undef PG8_SB
#undef PG8_STAGE
#undef PG8_LDA
#undef PG8_LDB
#undef PG8_MMA
#undef PG8_WAIT_V
#undef PG8_WAIT_L
#undef PG8_BAR
#undef PG8_SCHED
}
}

#ifndef MK_EN
#define MK_EN 0xFFFF
#endif
#ifndef MK_DBG_STOP
#define MK_DBG_STOP 0
#endif
#ifndef MK_DBG_BUF
#define MK_DBG_BUF 0
#endif
#ifndef MK_NAIVE_SCAN
#define MK_NAIVE_SCAN 0
#endif
#ifndef MK_ONE_LAUNCH
#define MK_ONE_LAUNCH 0
#endif
#define GAS __attribute__((address_space(1)))
#define LAS __attribute__((address_space(3)))
typedef unsigned short bf16;
typedef unsigned v4u __attribute__((ext_vector_type(4)));
typedef unsigned v2u __attribute__((ext_vector_type(2)));
typedef float f32x4 __attribute__((ext_vector_type(4)));
typedef float f32x2 __attribute__((ext_vector_type(2)));
#define RLX_AGENT __ATOMIC_RELAXED, __HIP_MEMORY_SCOPE_AGENT
#define LDS_WAIT() asm volatile("s_waitcnt lgkmcnt(0)" ::: "memory")
#define VM_WAIT() asm volatile("s_waitcnt vmcnt(0)" ::: "memory")

constexpr int NWAVES = 8;
constexpr int D = 1024, M = 16384, NCTXROWS = 8192, DEPTH = 4, SEQ = 256, DSEQ = 2048, NB = 32, NDB = 4;
constexpr int PIN = 2816, DFF = 2816, NDEC = 2560, NAUX = 256, NLRU = 2048;
constexpr int C_R = 0, C_K = 512, C_V = 1024, C_XW = 1536, C_XB = 1792, C_GB = 2304;
constexpr float DECAY_SCALE = 0.6065306597126334f;
enum { I_XP = 0, I_XS, I_SRWKV, I_SLRU, I_C, I_CCTX, I_LN1G, I_WMOD, I_BMOD, I_WIN, I_RW_W0, I_RW_WUP, I_RW_A0, I_RW_AUP, I_RW_GUP, I_RW_KK, I_RW_KA, I_RW_RK,
       I_RW_LNXG, I_RW_LNXB, I_LRU_CW, I_LRU_CB, I_LRU_GAW, I_LRU_GAB, I_LRU_GXW, I_LRU_GXB, I_LRU_LAM, I_WOUT, I_LN2G, I_WUP, I_FCW, I_FCB, I_WDOWN, I_LNFG, N_IN };
constexpr size_t O_Y = 0, O_SRWKV = 16777216, O_SLRU = 16777216 + 8388608, OUT_TOTAL = 16777216 + 8388608 + 131072;
constexpr size_t MiB = 1u << 20;
constexpr size_t WS_CTL = 0, CTL_ZERO_BYTES = 1 * MiB;
constexpr size_t WS_MOD = 1 * MiB;
constexpr size_t WS_SPT = 1 * MiB + 512 * 1024;
constexpr size_t WS_MODP = 2 * MiB;
constexpr size_t WS_W = 8 * MiB;
constexpr size_t WL_STRIDE = 26 * MiB + MiB / 4, WL_IN = 0, WL_OUT = 5 * MiB + MiB / 2, WL_UP = WL_OUT + 2 * MiB, WL_DOWN = WL_UP + 11 * MiB, WL_AUX = WL_DOWN + 5 * MiB + MiB / 2, WL_LRU = WL_AUX + MiB + MiB / 4;
static_assert(WL_LRU + 1 * MiB == WL_STRIDE, "weight map");
constexpr size_t WS_XN = WS_W + 4 * WL_STRIDE;
constexpr size_t WS_PROJ = WS_XN + 32 * MiB;
constexpr size_t WS_DEC = WS_PROJ + 88 * MiB;
constexpr size_t WS_LRU = WS_DEC + 80 * MiB;
constexpr size_t WS_END = WS_LRU + 64 * MiB;
static_assert(WS_END == 377 * MiB, "ws map");
constexpr int CW_BAR = 4096;

__device__ __forceinline__ unsigned f2bf(float f) { unsigned u = __builtin_bit_cast(unsigned, f); return (u + 0x7fffu + ((u >> 16) & 1u)) >> 16; }
__device__ __forceinline__ unsigned pk2(float lo, float hi) { return pg8::cvt_pk_bf16(lo, hi); }
__device__ __forceinline__ float bflo(unsigned w) { return __builtin_bit_cast(float, w << 16); }
__device__ __forceinline__ float bfhi(unsigned w) { return __builtin_bit_cast(float, w & 0xffff0000u); }
__device__ __forceinline__ float bf2f(bf16 h) { return __builtin_bit_cast(float, (unsigned)h << 16); }
__device__ __forceinline__ float fsigmoid(float x) { return __builtin_amdgcn_rcpf(1.0f + __builtin_amdgcn_exp2f(-1.4426950409f * x)); }
__device__ __forceinline__ float ftanh(float x) { return 2.0f * fsigmoid(2.0f * x) - 1.0f; }
__device__ __forceinline__ float gelu_tanh(float x) { const float z = 0.7978845608f * (x + 0.044715f * x * x * x); return x * fsigmoid(2.0f * z); }
__device__ __forceinline__ float fexp(float x) { return __builtin_amdgcn_exp2f(1.4426950409f * x); }
__device__ __forceinline__ float wave_sum(float v) {
#pragma unroll
    for (int o = 1; o < 64; o <<= 1) v += __shfl_xor(v, o);
    return v;
}

#define XB_TMO      128
#define XB_XCNT(j)  (256  + 64 * (j))
#define XB_XSUB(j)  (1280 + 64 * (j))
#define XB_XGEN(j)  (2304 + 64 * (j))
#define XB_TOP      3328
#define XB_TOPGEN   3392
#define XCD_BAR_WORDS 3456
#define XB_SPIN_CAP (1u << 20)
__device__ __forceinline__ unsigned xb_ld(unsigned* p)              { return __hip_atomic_load(p, __ATOMIC_RELAXED, __HIP_MEMORY_SCOPE_AGENT); }
__device__ __forceinline__ unsigned xb_add(unsigned* p, unsigned v) { return __hip_atomic_fetch_add(p, v, __ATOMIC_RELAXED, __HIP_MEMORY_SCOPE_AGENT); }
__device__ __forceinline__ unsigned xb_xcc_id() { return (unsigned)__builtin_amdgcn_s_getreg((3 << 11) | 20) & 0xFu; }
#define XB_SPIN(cond, bar) do { unsigned _sp = 0; while (cond) { __builtin_amdgcn_s_sleep(1); \
    if ((++_sp & 255u) == 0u) { if (xb_ld(&(bar)[XB_TMO])) break; if (_sp > XB_SPIN_CAP) { atomicAdd(&(bar)[XB_TMO], 1u); break; } } } } while (0)
struct XcdBarrier { unsigned* bar; unsigned x; volatile LAS unsigned* st; };
__device__ __forceinline__ XcdBarrier xcd_barrier_post(unsigned* bar, volatile LAS unsigned* st) {
    XcdBarrier b; b.bar = bar; b.x = xb_xcc_id(); b.st = st;
    if (threadIdx.x == 0) (void)xb_add(&bar[XB_XCNT(b.x)], 1u);
    return b;
}
__device__ __forceinline__ void xcd_barrier_complete(unsigned* bar, unsigned x, unsigned& nloc, unsigned& nx) {
    const unsigned G = gridDim.x * gridDim.y * gridDim.z;
    unsigned sum, cnt, mine, sp = 0u;
    for (;;) {
        sum = 0u; cnt = 0u; mine = 0u;
#pragma unroll
        for (unsigned j = 0; j < 16; ++j) { const unsigned c = xb_ld(&bar[XB_XCNT(j)]); sum += c; cnt += (c > 0u) ? 1u : 0u; mine = (j == x) ? c : mine; }
        if (sum == G) break;
        __builtin_amdgcn_s_sleep(1);
        if ((++sp & 255u) == 0u) { if (xb_ld(&bar[XB_TMO])) break; if (sp > XB_SPIN_CAP) { atomicAdd(&bar[XB_TMO], 1u); break; } }
    }
    nloc = mine > 0u ? mine : 1u; nx = cnt > 0u ? cnt : 1u;
}
__device__ __forceinline__ void xcd_barrier(const XcdBarrier& b) {
    asm volatile("s_waitcnt vmcnt(0)" ::: "memory");
    __syncthreads();
    if (threadIdx.x == 0) {
        unsigned* bar = b.bar;
        __builtin_amdgcn_s_waitcnt(0);
        unsigned nloc = b.st[0], nx = b.st[1];
        if (nloc == 0u) { xcd_barrier_complete(bar, b.x, nloc, nx); b.st[0] = nloc; b.st[1] = nx; }
        const unsigned old = xb_add(&bar[XB_XSUB(b.x)], 1u);
        const unsigned gen = old / nloc;
        if (old + 1u == (gen + 1u) * nloc) {
            __builtin_amdgcn_fence(__ATOMIC_RELEASE, "agent");
            asm volatile("s_waitcnt vmcnt(0)" ::: "memory");
            const unsigned og = xb_add(&bar[XB_TOP], 1u);
            const unsigned tg = og / nx;
            if (og + 1u == (tg + 1u) * nx) xb_add(&bar[XB_TOPGEN], 1u);
            else XB_SPIN(xb_ld(&bar[XB_TOPGEN]) == tg, bar);
            __builtin_amdgcn_fence(__ATOMIC_ACQUIRE, "agent");
            xb_add(&bar[XB_XGEN(b.x)], 1u);
            asm volatile("s_waitcnt vmcnt(0)" ::: "memory");
        } else {
            XB_SPIN(xb_ld(&bar[XB_XGEN(b.x)]) == gen, bar);
            __builtin_amdgcn_fence(__ATOMIC_ACQUIRE, "agent");
            asm volatile("s_waitcnt vmcnt(0)" ::: "memory");
        }
    }
    __syncthreads();
}

constexpr int RING_OFF = 0, RING_BYTES = 131072;
constexpr int XBUF_OFF = RING_BYTES;
constexpr int LDSCTL_OFF = 155648, MISC_OFF = LDSCTL_OFF + 320;
constexpr int LDS_BYTES = 163840;
static_assert(MISC_OFF + 128 <= LDS_BYTES, "LDS map");

struct Args { const float* in[N_IN]; float* out; unsigned char* ws; int ph_lo, ph_hi; };
static_assert(sizeof(Args) == N_IN * 8 + 24, "Args has no padding");

struct Frame {
    LAS unsigned char* lds;
    int tid, lane, wave, vcu, G;
    const float* const* in;
    float* out; unsigned char* ws;
};
__device__ __forceinline__ bf16* wlayer(const Frame& F, int l, size_t off) { return (bf16*)(F.ws + WS_W + (size_t)l * WL_STRIDE + off); }
__device__ __forceinline__ const float* modp(const Frame& F, int l, int bi) { return (const float*)(F.ws + WS_MOD) + ((size_t)l * 5 + bi) * 6144; }
__device__ __forceinline__ int row_bidx(int r) { return r < NCTXROWS ? 0 : 1 + ((r - NCTXROWS) >> 11); }

namespace pg8 {
struct EpiProj {
    static constexpr bool PERM = true, AFTER_DRAIN = false;
    bf16_t* O; bf16_t* AUX;
    __device__ __forceinline__ void operator()(const f32x4 (&acc)[2][2][4][2], const Unit& u, int wr, int wc, int fr, int fq) const {
        const int row0 = u.pm * BM + wr * 64 + fr; const int ct0 = wc * 32 + 8 * fq; const int col0 = u.pn * BM + ct0;
#pragma unroll
        for (int ai = 0; ai < 2; ++ai)
#pragma unroll
            for (int m = 0; m < 4; ++m) { const size_t row = (size_t)(row0 + ai * HALF + m * 16); bf16_t* rowp = O + row * PIN + col0;
#pragma unroll
                for (int bj = 0; bj < 2; ++bj) { const f32x4 v0 = acc[ai][bj][m][0], v1 = acc[ai][bj][m][1];
                    u32x4 w; w.x = cvt_pk_bf16(v0[0], v0[1]); w.y = cvt_pk_bf16(v0[2], v0[3]); w.z = cvt_pk_bf16(v1[0], v1[1]); w.w = cvt_pk_bf16(v1[2], v1[3]);
                    *(u32x4*)(rowp + bj * HALF) = w;
                    if (u.pn == 6) { float t[8] = {v0[0], v0[1], v0[2], v0[3], v1[0], v1[1], v1[2], v1[3]};
                        if (bj == 1) {
#pragma unroll
                            for (int e = 0; e < 8; ++e) t[e] = fsigmoid(t[e]); }
                        else if (wc < 2) {
#pragma unroll
                            for (int e = 0; e < 8; ++e) t[e] = ftanh(t[e]); }
                        u32x4 a; a.x = cvt_pk_bf16(t[0], t[1]); a.y = cvt_pk_bf16(t[2], t[3]); a.z = cvt_pk_bf16(t[4], t[5]); a.w = cvt_pk_bf16(t[6], t[7]);
                        *(u32x4*)(AUX + row * NAUX + ct0 + bj * HALF) = a; } } }
    }
};
struct EpiDec {
    static constexpr bool PERM = true, AFTER_DRAIN = false;
    bf16_t* O; const float* w0; const float* a0;
    __device__ __forceinline__ void operator()(const f32x4 (&acc)[2][2][4][2], const Unit& u, int wr, int wc, int fr, int fq) const {
        const int row0 = u.pm * BM + wr * 64 + fr; const int ct0 = wc * 32 + 8 * fq; const int col0 = u.pn * BM + ct0;
        const int kind = u.pn < 4 ? 0 : (u.pn < 8 ? 1 : 2);
        const float* bp = kind == 0 ? w0 + u.pn * 256 : a0 + (u.pn - 4) * 256;
        const float s = kind == 0 ? -DECAY_SCALE : 1.0f;
#pragma unroll
        for (int bj = 0; bj < 2; ++bj)
#pragma unroll
          for (int n = 0; n < 2; ++n) {
            const f32x4 b0 = kind < 2 ? *(const f32x4*)(bp + ct0 + bj * HALF + 4 * n) : (f32x4){0.f, 0.f, 0.f, 0.f};
#pragma unroll
            for (int ai = 0; ai < 2; ++ai)
#pragma unroll
                for (int m = 0; m < 4; ++m) { bf16_t* rowp = O + (size_t)(row0 + ai * HALF + m * 16) * NDEC + col0 + bj * HALF + 4 * n;
                    f32x4 v0 = acc[ai][bj][m][n] + b0;
                    if (kind < 2) {
#pragma unroll
                        for (int e = 0; e < 4; ++e) v0[e] = s * fsigmoid(v0[e]); }
                    v2u w; w.x = cvt_pk_bf16(v0[0], v0[1]); w.y = cvt_pk_bf16(v0[2], v0[3]);
                    *(v2u*)rowp = w; }
          }
    }
};
struct EpiLru {
    static constexpr bool PERM = false, AFTER_DRAIN = false;
    bf16_t* LRU; const bf16_t* XC; const float* gab; const float* gxb; const float* spt;
    __device__ __forceinline__ void operator()(const f32x4 (&acc)[2][2][4][2], const Unit& u, int wr, int wc, int fr, int fq) const {
        const int row0 = u.pm * BM + wr * 64 + fr; const int c0 = u.pn * 64 + wc * 16 + fq * 4;
        typedef float f2 __attribute__((ext_vector_type(2)));
#pragma unroll
        for (int d = 0; d < 2; ++d)
#pragma unroll
          for (int ep = 0; ep < 2; ++ep) {
            const int c2 = c0 + 2 * ep;
            const f2 bga = *(const f2*)(gab + d * 512 + c2), bgx = *(const f2*)(gxb + d * 512 + c2), sp = *(const f2*)(spt + d * 512 + c2);
#pragma unroll
            for (int ai = 0; ai < 2; ++ai)
#pragma unroll
                for (int m = 0; m < 4; ++m) { const size_t row = (size_t)(row0 + ai * HALF + m * 16);
                    const unsigned xw = *(const unsigned*)(XC + row * 512 + c2); const float xc[2] = {bflo(xw), bfhi(xw)};
                    float la[2], uu[2];
#pragma unroll
                    for (int e2 = 0; e2 < 2; ++e2) { const int e = 2 * ep + e2; const float rg = fsigmoid(acc[ai][0][m][d][e] + bga[e2]), ig = fsigmoid(acc[ai][1][m][d][e] + bgx[e2]);
                        la[e2] = sp[e2] * rg; const float x2 = 2.0f * la[e2];
                        const float em1 = x2 > -0.25f ? -x2 * (1.0f + x2 * (0.5f + x2 * (0.16666667f + x2 * (0.041666668f + x2 * (0.0083333338f + x2 * 0.0013888889f))))) : 1.0f - fexp(x2);
                        uu[e2] = sqrtf(em1) * (ig * xc[e2]); }
                    bf16_t* p = LRU + (row * 2 + d) * 1024 + c2;
                    *(unsigned*)p = cvt_pk_bf16(la[0], la[1]); *(unsigned*)(p + 512) = cvt_pk_bf16(uu[0], uu[1]); }
          }
    }
};
struct EpiRes {
    static constexpr bool PERM = false, AFTER_DRAIN = false;
    const float* baseA; const float* baseB; float* out; const float* gate0;
    __device__ __forceinline__ void operator()(const f32x4 (&acc)[2][2][4][2], const Unit& u, int wr, int wc, int fr, int fq) const {
        const int row0 = u.pm * BM + wr * 64 + fr, col0 = u.pn * BM + wc * 32 + 4 * fq;
        const int bi = u.pm < 32 ? 0 : 1 + ((u.pm - 32) >> 3);
        const float* gp = gate0 + (size_t)bi * 6144 + col0;
        const float* bs = u.pm < 32 ? baseA : baseB - (size_t)NCTXROWS * D;
        f32x4 gv[2][2];
#pragma unroll
        for (int bj = 0; bj < 2; ++bj)
#pragma unroll
            for (int n = 0; n < 2; ++n) gv[bj][n] = *(const f32x4*)(gp + bj * HALF + n * 16);
#pragma unroll
        for (int ai = 0; ai < 2; ++ai)
#pragma unroll
            for (int m = 0; m < 4; ++m) { const size_t off = (size_t)(row0 + ai * HALF + m * 16) * D + col0;
#pragma unroll
                for (int bj = 0; bj < 2; ++bj)
#pragma unroll
                    for (int n = 0; n < 2; ++n) { const f32x4 b = *(const f32x4*)(bs + off + bj * HALF + n * 16); *(f32x4*)(out + off + bj * HALF + n * 16) = b + gv[bj][n] * acc[ai][bj][m][n]; } }
    }
};
template <int CTRL, bool BC> __device__ __forceinline__ float dpp_f(float oldv, float x) {
    return __builtin_bit_cast(float, __builtin_amdgcn_update_dpp(__builtin_bit_cast(int, oldv), __builtin_bit_cast(int, x), CTRL, 0xf, 0xf, BC));
}
struct EpiFfn {
    static constexpr bool PERM = true, AFTER_DRAIN = false;
    bf16_t* ACT; const float* cw; const float* cb; PG8_LAS float* xbuf;
    __device__ __forceinline__ void operator()(const f32x4 (&acc)[2][2][4][2], const Unit& u, int wr, int wc, int fr, int fq) const {
        const bool ctx = u.pm < 32;
        const int wid = wr * 4 + wc;
        if (ctx) {
#pragma unroll
            for (int ai = 0; ai < 2; ++ai)
#pragma unroll
                for (int bj = 0; bj < 2; ++bj)
#pragma unroll
                    for (int n = 0; n < 2; ++n) {
                        if (fr == 0)  *(PG8_LAS f32x4*)(xbuf + ((((wid * 2 + ai) * 2 + 0) * 4 + fq) * 4 + bj * 2 + n) * 4) = acc[ai][bj][0][n];
                        if (fr == 15) *(PG8_LAS f32x4*)(xbuf + ((((wid * 2 + ai) * 2 + 1) * 4 + fq) * 4 + bj * 2 + n) * 4) = acc[ai][bj][3][n];
                    }
            asm volatile("s_waitcnt lgkmcnt(0)" ::: "memory"); __builtin_amdgcn_s_barrier(); asm volatile("" ::: "memory");
        }
        const int row0 = u.pm * BM + wr * 64 + fr; const int ct0 = wc * 32 + 8 * fq;
#pragma unroll
        for (int n = 0; n < 2; ++n)
#pragma unroll
          for (int ep = 0; ep < 2; ++ep) {
            const int ca = u.pn * 128 + ct0 + 4 * n + 2 * ep;
            typedef float f2 __attribute__((ext_vector_type(2)));
            const f2 w0a = *(const f2*)(cw + ca), w1a = *(const f2*)(cw + 5632 + ca), w2a = *(const f2*)(cw + 2 * 5632 + ca), cba = *(const f2*)(cb + ca);
            const f2 w0b = *(const f2*)(cw + 2816 + ca), w1b = *(const f2*)(cw + 5632 + 2816 + ca), w2b = *(const f2*)(cw + 2 * 5632 + 2816 + ca), cbb = *(const f2*)(cb + 2816 + ca);
#pragma unroll
            for (int ai = 0; ai < 2; ++ai) {
                const int blk = 2 * ai + wr;
                f2 pa = {0.f, 0.f}, pb = pa, na = pa, nb = pa;
                if (ctx && blk > 0) { const int pw = ((blk - 1) & 1) * 4 + wc, pai = (blk - 1) >> 1;
                    pa = *(const PG8_LAS f2*)(xbuf + ((((pw * 2 + pai) * 2 + 1) * 4 + fq) * 4 + 0 * 2 + n) * 4 + 2 * ep); pb = *(const PG8_LAS f2*)(xbuf + ((((pw * 2 + pai) * 2 + 1) * 4 + fq) * 4 + 1 * 2 + n) * 4 + 2 * ep); }
                if (ctx && blk < 3) { const int nw = ((blk + 1) & 1) * 4 + wc, nai = (blk + 1) >> 1;
                    na = *(const PG8_LAS f2*)(xbuf + ((((nw * 2 + nai) * 2 + 0) * 4 + fq) * 4 + 0 * 2 + n) * 4 + 2 * ep); nb = *(const PG8_LAS f2*)(xbuf + ((((nw * 2 + nai) * 2 + 0) * 4 + fq) * 4 + 1 * 2 + n) * 4 + 2 * ep); }
#pragma unroll
                for (int m = 0; m < 4; ++m) {
                    float o[2];
#pragma unroll
                    for (int e2 = 0; e2 < 2; ++e2) { const int e = 2 * ep + e2;
                        const float xa = acc[ai][0][m][n][e], xb = acc[ai][1][m][n][e];
                        const float ta = m > 0 ? dpp_f<0x10F, true>(0.f, acc[ai][0][m > 0 ? m - 1 : 0][n][e]) : pa[e2];
                        const float tb = m > 0 ? dpp_f<0x10F, true>(0.f, acc[ai][1][m > 0 ? m - 1 : 0][n][e]) : pb[e2];
                        const float ba = m < 3 ? dpp_f<0x11F, true>(0.f, acc[ai][0][m < 3 ? m + 1 : 3][n][e]) : na[e2];
                        const float bb = m < 3 ? dpp_f<0x11F, true>(0.f, acc[ai][1][m < 3 ? m + 1 : 3][n][e]) : nb[e2];
                        const float upa = dpp_f<0x111, false>(ta, xa), upb = dpp_f<0x111, false>(tb, xb);
                        const float dna = dpp_f<0x101, false>(ba, xa), dnb = dpp_f<0x101, false>(bb, xb);
                        const float ua = cba[e2] + w0a[e2] * upa + w1a[e2] * xa + w2a[e2] * dna;
                        const float ub = cbb[e2] + w0b[e2] * upb + w1b[e2] * xb + w2b[e2] * dnb;
                        o[e2] = gelu_tanh(ua) * ub; }
                    *(unsigned*)(ACT + (size_t)(row0 + ai * HALF + m * 16) * DFF + ca) = cvt_pk_bf16(o[0], o[1]);
                }
            }
          }
    }
};
}

template <class RowMap>
__device__ __forceinline__ void transpose_item(const float* W, int srcN, int k0, int n0, bf16* dst, int dstK, int kdst0, RowMap rm, LAS float* scr, int lane) {
#pragma unroll 8
    for (int i = 0; i < 32; ++i) { const int kk = 2 * i + (lane >> 5); scr[kk * 33 + (lane & 31)] = W[(size_t)(k0 + kk) * srcN + n0 + (lane & 31)]; }
    LDS_WAIT(); asm volatile("" ::: "memory");
    const int c = lane & 7;
#pragma unroll
    for (int j = 0; j < 4; ++j) { const int n = (lane >> 3) + 8 * j; const LAS float* s = scr + (8 * c) * 33 + n;
        v4u o; o.x = pk2(s[0 * 33], s[1 * 33]); o.y = pk2(s[2 * 33], s[3 * 33]); o.z = pk2(s[4 * 33], s[5 * 33]); o.w = pk2(s[6 * 33], s[7 * 33]);
        *(GAS v4u*)(dst + (size_t)rm(n) * dstK + kdst0 + 8 * c) = o; }
    LDS_WAIT(); asm volatile("" ::: "memory");
}
constexpr int IT_IN = 16 * 88, IT_OUT = 16 * 32, IT_UP = 16 * 176, IT_DOWN = 44 * 32, IT_AUX = 96, IT_LRU = 64, IT_LAYER = IT_IN + IT_OUT + IT_UP + IT_DOWN + IT_AUX + IT_LRU;
constexpr int ZR_LAYER = NDEC + NLRU;
constexpr int N_T0 = DEPTH * IT_LAYER, N_T1 = DEPTH * ZR_LAYER, N_T2 = DEPTH * 8 * 24;
__device__ __forceinline__ void p0_prologue(Frame& F) {
    LAS float* scr = (LAS float*)(F.lds + RING_OFF + F.wave * 16384);
    const int gw = F.vcu * NWAVES + F.wave, NGW = F.G * NWAVES; const int lane = F.lane;
    for (int t = gw; t < N_T2; t += NGW) {
        const int l = t / 192, ks = (t % 192) / 24, nb = t % 24;
        const float* W = F.in[I_WMOD] + ((size_t)l * 1024 + ks * 128) * 6144 + nb * 256 + lane * 4;
        f32x4 a0 = {0.f, 0.f, 0.f, 0.f}, a1 = a0, a2 = a0, a3 = a0, a4 = a0;
#pragma unroll 4
        for (int k = 0; k < 128; ++k) {
            const f32x4 w = *(const f32x4*)(W + (size_t)k * 6144); const int kk = ks * 128 + k;
            const float c0 = F.in[I_CCTX][kk], c1 = F.in[I_C][kk], c2 = F.in[I_C][1024 + kk], c3 = F.in[I_C][2048 + kk], c4 = F.in[I_C][3072 + kk];
            a0 += (c0 * fsigmoid(c0)) * w; a1 += (c1 * fsigmoid(c1)) * w; a2 += (c2 * fsigmoid(c2)) * w; a3 += (c3 * fsigmoid(c3)) * w; a4 += (c4 * fsigmoid(c4)) * w;
        }
        float* P = (float*)(F.ws + WS_MODP) + (((size_t)l * 8 + ks) * 5) * 6144 + nb * 256 + lane * 4;
        *(f32x4*)(P) = a0; *(f32x4*)(P + 6144) = a1; *(f32x4*)(P + 2 * 6144) = a2; *(f32x4*)(P + 3 * 6144) = a3; *(f32x4*)(P + 4 * 6144) = a4;
    }
    for (int it = gw; it < N_T0; it += NGW) {
        const int l = it / IT_LAYER; int r = it % IT_LAYER;
        if (r < IT_IN) { const int kb = r / 88, nb = r % 88; transpose_item(F.in[I_WIN] + (size_t)l * 1024 * PIN, PIN, 64 * kb, 32 * nb, wlayer(F, l, WL_IN), 1024, 64 * kb, [=](int n) { return 32 * nb + n; }, scr, lane); continue; } r -= IT_IN;
        if (r < IT_OUT) { const int kb = r / 32, nb = r % 32; transpose_item(F.in[I_WOUT] + (size_t)l * 1024 * 1024, 1024, 64 * kb, 32 * nb, wlayer(F, l, WL_OUT), 1024, 64 * kb, [=](int n) { return 32 * nb + n; }, scr, lane); continue; } r -= IT_OUT;
        if (r < IT_UP) { const int kb = r / 176, nb = r % 176; const int n0 = 32 * nb; const int nn = n0 < DFF ? n0 : n0 - DFF; const int rb = 256 * (nn / 128) + (n0 < DFF ? 0 : 128) + (nn % 128);
            transpose_item(F.in[I_WUP] + (size_t)l * 1024 * 5632, 5632, 64 * kb, n0, wlayer(F, l, WL_UP), 1024, 64 * kb, [=](int n) { return rb + n; }, scr, lane); continue; } r -= IT_UP;
        if (r < IT_DOWN) { const int kb = r / 32, nb = r % 32; transpose_item(F.in[I_WDOWN] + (size_t)l * DFF * 1024, 1024, 64 * kb, 32 * nb, wlayer(F, l, WL_DOWN), DFF, 64 * kb, [=](int n) { return 32 * nb + n; }, scr, lane); continue; } r -= IT_DOWN;
        if (r < IT_AUX) {
            if (r < 32) { const int d = r / 16, nb = r % 16; transpose_item(F.in[I_RW_WUP] + ((size_t)l * 2 + d) * 64 * 512, 512, 0, 32 * nb, wlayer(F, l, WL_AUX), NAUX, 0, [=](int n) { return d * 512 + 32 * nb + n; }, scr, lane); }
            else if (r < 64) { const int d = (r - 32) / 16, nb = r % 16; transpose_item(F.in[I_RW_AUP] + ((size_t)l * 2 + d) * 64 * 512, 512, 0, 32 * nb, wlayer(F, l, WL_AUX), NAUX, 64, [=](int n) { return 1024 + d * 512 + 32 * nb + n; }, scr, lane); }
            else { const int kb = (r - 64) / 16, nb = r % 16; transpose_item(F.in[I_RW_GUP] + (size_t)l * 128 * 512, 512, 64 * kb, 32 * nb, wlayer(F, l, WL_AUX), NAUX, 128 + 64 * kb, [=](int n) { return 2048 + 32 * nb + n; }, scr, lane); }
            continue; } r -= IT_AUX;
        { const int q = r / 16, h = (r % 16) / 2, nb = r % 2;
          const float* src = (q < 2 ? F.in[I_LRU_GAW] : F.in[I_LRU_GXW]) + (((size_t)l * 2 + (q & 1)) * 8 + h) * 4096;
          transpose_item(src, 64, 0, 32 * nb, wlayer(F, l, WL_LRU), 256, 64 * (h & 3), [=](int n) { const int j = 32 * nb + n; return 256 * h + 128 * (q >> 1) + 16 * (q & 1) + 32 * (j >> 4) + (j & 15); }, scr, lane); }
    }
    for (int t = gw; t < N_T1; t += NGW) {
        const int l = t / ZR_LAYER, r = t % ZR_LAYER; const int k = 4 * lane;
        if (r < NDEC) { const int lo = r < 1024 ? 0 : (r < 2048 ? 64 : 128), hi = r < 1024 ? 64 : (r < 2048 ? 128 : 256);
            if (k < lo || k >= hi) *(GAS v2u*)(wlayer(F, l, WL_AUX) + (size_t)r * NAUX + k) = (v2u){0u, 0u}; }
        else { const int rr = r - NDEC, h = rr >> 8; const int lo = 64 * (h & 3);
            if (k < lo || k >= lo + 64) *(GAS v2u*)(wlayer(F, l, WL_LRU) + (size_t)rr * 256 + k) = (v2u){0u, 0u}; }
    }
}
__device__ __forceinline__ void p1_modreduce(Frame& F) {
    const int gt = (F.vcu * NWAVES + F.wave) * 64 + F.lane, NT = F.G * NWAVES * 64;
    for (int i = gt; i < DEPTH * 5 * 6144; i += NT) { const int l = i / (5 * 6144), r = i % (5 * 6144), n = r % 6144, bi = r / 6144;
        float s = F.in[I_BMOD][l * 6144 + n];
#pragma unroll
        for (int ks = 0; ks < 8; ++ks) s += ((const float*)(F.ws + WS_MODP))[(((size_t)l * 8 + ks) * 5 + bi) * 6144 + n];
        ((float*)(F.ws + WS_MOD))[i] = s; }
    for (int i = gt; i < DEPTH * 1024; i += NT) { const float x = -F.in[I_LRU_LAM][i]; ((float*)(F.ws + WS_SPT))[i] = -8.0f * (fmaxf(x, 0.f) + log1pf(expf(-fabsf(x)))); }
}
__device__ __forceinline__ void modnorm_row(const float* xrow, bf16* orow, const float* g, const float* sc, const float* sh, int lane) {
    const GAS f32x4* xr = (const GAS f32x4*)xrow + lane;
    f32x4 v[4]; float s = 0.f;
#pragma unroll
    for (int j = 0; j < 4; ++j) { v[j] = xr[64 * j]; s += (v[j].x * v[j].x + v[j].y * v[j].y) + (v[j].z * v[j].z + v[j].w * v[j].w); }
    const float rstd = 1.0f / sqrtf(wave_sum(s) * (1.f / D) + 1e-6f);
    GAS unsigned long long* o8 = (GAS unsigned long long*)orow + lane;
#pragma unroll
    for (int j = 0; j < 4; ++j) { const int c = 4 * lane + 256 * j; const f32x4 gg = *(const f32x4*)(g + c), ss = *(const f32x4*)(sc + c), hh = *(const f32x4*)(sh + c);
        const f32x4 y = v[j] * rstd * gg * (ss + 1.0f) + hh;
        o8[64 * j] = (unsigned long long)pk2(y.x, y.y) | ((unsigned long long)pk2(y.z, y.w) << 32); }
}
__device__ __forceinline__ const float* xrow_in(const Frame& F, int r) { return r < NCTXROWS ? F.in[I_XP] + (size_t)r * D : F.in[I_XS] + (size_t)(r - NCTXROWS) * D; }
__device__ __forceinline__ void p_modnorm(Frame& F, int l, int which, bool from_input) {
    const int gw = F.vcu * NWAVES + F.wave, NGW = F.G * NWAVES;
    const float* g = F.in[which ? I_LN2G : I_LN1G] + l * D;
    for (int r = gw; r < M; r += NGW) { const float* mp = modp(F, l, row_bidx(r)) + (which ? 3072 : 0);
        modnorm_row(from_input ? xrow_in(F, r) : F.out + (size_t)r * D, (bf16*)(F.ws + WS_XN) + (size_t)r * D, g, mp + 1024, mp, F.lane); }
}
__device__ __forceinline__ void p_finalnorm(Frame& F) {
    const int gw = F.vcu * NWAVES + F.wave, NGW = F.G * NWAVES; const float* g = F.in[I_LNFG];
    for (int r = gw; r < M; r += NGW) { GAS f32x4* xr = (GAS f32x4*)(F.out + (size_t)r * D) + F.lane;
        f32x4 v[4]; float s = 0.f;
#pragma unroll
        for (int j = 0; j < 4; ++j) { v[j] = xr[64 * j]; s += (v[j].x * v[j].x + v[j].y * v[j].y) + (v[j].z * v[j].z + v[j].w * v[j].w); }
        const float rstd = 1.0f / sqrtf(wave_sum(s) * (1.f / D) + 1e-6f);
#pragma unroll
        for (int j = 0; j < 4; ++j) { const f32x4 gg = *(const f32x4*)(g + 4 * F.lane + 256 * j); xr[64 * j] = v[j] * rstd * gg; } }
}
__device__ __forceinline__ void p_lruconv(Frame& F, int l) {
    const int gt = (F.vcu * NWAVES + F.wave) * 64 + F.lane, NT = F.G * NWAVES * 64;
    const bf16* PROJ = (const bf16*)(F.ws + WS_PROJ); bf16* XC = (bf16*)(F.ws + WS_XN);
    const float* cw = F.in[I_LRU_CW] + l * 4 * 512; const float* cb = F.in[I_LRU_CB] + l * 512;
    for (int i = gt; i < M * 64; i += NT) { const int r = i >> 6, c = (i & 63) * 8;
        const int p = r < NCTXROWS ? (r & 255) : ((r - NCTXROWS) & 63), L = r < NCTXROWS ? 256 : 64;
        float a[8];
#pragma unroll
        for (int e = 0; e < 8; ++e) a[e] = cb[c + e];
#pragma unroll
        for (int j = 0; j < 4; ++j) { const int q = p + j - 2; if (q < 0 || q >= L) continue;
            const v4u w = *(const GAS v4u*)(PROJ + (size_t)(r + j - 2) * PIN + C_XB + c); const float* wj = cw + j * 512 + c;
            a[0] += bflo(w.x) * wj[0]; a[1] += bfhi(w.x) * wj[1]; a[2] += bflo(w.y) * wj[2]; a[3] += bfhi(w.y) * wj[3];
            a[4] += bflo(w.z) * wj[4]; a[5] += bfhi(w.z) * wj[5]; a[6] += bflo(w.w) * wj[6]; a[7] += bfhi(w.w) * wj[7]; }
        v4u o; o.x = pk2(a[0], a[1]); o.y = pk2(a[2], a[3]); o.z = pk2(a[4], a[5]); o.w = pk2(a[6], a[7]);
        *(GAS v4u*)(XC + (size_t)r * 512 + c) = o; }
}
__device__ __forceinline__ void rwkv_scan_naive(Frame& F, int l, int task, LAS float* scr) {
    const bool lat = task < 64; const int tt0 = lat ? task : task - 64; const int s = tt0 >> 4, d = (tt0 >> 3) & 1, h = tt0 & 7;
    const int T = lat ? DSEQ : SEQ; const int row0 = lat ? NCTXROWS + s * DSEQ : s * SEQ; const int lane = F.lane;
    const bf16* PROJ = (const bf16*)(F.ws + WS_PROJ); bf16* DEC = (bf16*)(F.ws + WS_DEC);
    float S[64];
    if (lat) { const float* sp = F.in[I_SRWKV] + ((((size_t)s * 4 + l) * 2 + d) * 8 + h) * 4096 + lane * 64;
#pragma unroll
        for (int j = 0; j < 64; j += 4) { const f32x4 v = *(const f32x4*)(sp + j); S[j] = v.x; S[j + 1] = v.y; S[j + 2] = v.z; S[j + 3] = v.w; } }
    else {
#pragma unroll
        for (int j = 0; j < 64; ++j) S[j] = 0.f; }
    const float kkw = F.in[I_RW_KK][l * 512 + h * 64 + lane], kaw = F.in[I_RW_KA][l * 512 + h * 64 + lane];
    for (int tt = 0; tt < T; ++tt) {
        const int t = d ? T - 1 - tt : tt; const size_t r = (size_t)(row0 + t);
        const float kj = bf2f(PROJ[r * PIN + C_K + h * 64 + lane]), rj = bf2f(PROJ[r * PIN + C_R + h * 64 + lane]), vi = bf2f(PROJ[r * PIN + C_V + h * 64 + lane]);
        const float lw = bf2f(DEC[r * NDEC + d * 512 + h * 64 + lane]), aj = bf2f(DEC[r * NDEC + 1024 + d * 512 + h * 64 + lane]);
        float kk = kj * kkw; const float nrm = wave_sum(kk * kk); kk *= 1.0f / sqrtf(nrm + 1e-12f);
        scr[lane] = kk; scr[64 + lane] = fexp(lw); scr[128 + lane] = kk * aj; scr[192 + lane] = kj * (1.0f + (aj - 1.0f) * kaw); scr[256 + lane] = rj;
        LDS_WAIT(); asm volatile("" ::: "memory");
        float sa0 = 0.f, sa1 = 0.f, sa2 = 0.f, sa3 = 0.f;
#pragma unroll
        for (int j = 0; j < 64; j += 4) { const f32x4 q = *(const LAS f32x4*)(scr + j); sa0 += S[j] * q.x; sa1 += S[j + 1] * q.y; sa2 += S[j + 2] * q.z; sa3 += S[j + 3] * q.w; }
        const float sa = (sa0 + sa1) + (sa2 + sa3);
        float y0 = 0.f, y1 = 0.f, y2 = 0.f, y3 = 0.f;
#pragma unroll
        for (int j = 0; j < 64; j += 4) { const f32x4 w = *(const LAS f32x4*)(scr + 64 + j), b = *(const LAS f32x4*)(scr + 128 + j), kd = *(const LAS f32x4*)(scr + 192 + j), rr = *(const LAS f32x4*)(scr + 256 + j);
            S[j] = S[j] * w.x - sa * b.x + vi * kd.x; S[j + 1] = S[j + 1] * w.y - sa * b.y + vi * kd.y; S[j + 2] = S[j + 2] * w.z - sa * b.z + vi * kd.z; S[j + 3] = S[j + 3] * w.w - sa * b.w + vi * kd.w;
            y0 += S[j] * rr.x; y1 += S[j + 1] * rr.y; y2 += S[j + 2] * rr.z; y3 += S[j + 3] * rr.w; }
        LDS_WAIT(); asm volatile("" ::: "memory");
        DEC[r * NDEC + d * 512 + h * 64 + lane] = (bf16)f2bf((y0 + y1) + (y2 + y3));
    }
    if (!lat) { float* op = F.out + O_SRWKV + ((((size_t)s * 4 + l) * 2 + d) * 8 + h) * 4096 + lane * 64;
#pragma unroll
        for (int j = 0; j < 64; j += 4) *(f32x4*)(op + j) = (f32x4){S[j], S[j + 1], S[j + 2], S[j + 3]}; }
}
__device__ __forceinline__ void lru_scan_naive(Frame& F, int l, int task) {
    const bool lat = task < 64; const int tt0 = lat ? task : task - 64; const int s = tt0 >> 4, d = (tt0 >> 3) & 1, cbk = tt0 & 7;
    const int T = lat ? DSEQ : SEQ; const int row0 = lat ? NCTXROWS + s * DSEQ : s * SEQ; const int c = cbk * 64 + F.lane;
    bf16* LRU = (bf16*)(F.ws + WS_LRU);
    float h = lat ? F.in[I_SLRU][(((size_t)s * 4 + l) * 2 + d) * 512 + c] : 0.f;
#pragma unroll 8
    for (int tt = 0; tt < T; ++tt) { const int t = d ? T - 1 - tt : tt; bf16* p = LRU + ((size_t)(row0 + t) * 2 + d) * 1024 + c;
        const float la = bf2f(p[0]), u = bf2f(p[512]); h = fexp(la) * h + u; p[512] = (bf16)f2bf(h); }
    if (!lat) F.out[O_SLRU + (((size_t)s * 4 + l) * 2 + d) * 512 + c] = h;
}
__device__ __forceinline__ void p_scan_naive(Frame& F, int l) {
    LAS float* scr = (LAS float*)(F.lds + RING_OFF + F.wave * 2048);
    const int gwt = F.wave * F.G + F.vcu, NGW = F.G * NWAVES;
    for (int t = gwt; t < 1152; t += NGW) {
        if (t < 64) rwkv_scan_naive(F, l, t, scr);
        else if (t < 128) lru_scan_naive(F, l, t - 64);
        else if (t < 640) rwkv_scan_naive(F, l, t - 128 + 64, scr);
        else lru_scan_naive(F, l, t - 640 + 64);
    }
}
__device__ __forceinline__ void ld8(const bf16* p, float (&o)[8]) { const v4u w = *(const GAS v4u*)p; o[0] = bflo(w.x); o[1] = bfhi(w.x); o[2] = bflo(w.y); o[3] = bfhi(w.y); o[4] = bflo(w.z); o[5] = bfhi(w.z); o[6] = bflo(w.w); o[7] = bfhi(w.w); }
__device__ __forceinline__ void ld8f(const float* p, float (&o)[8]) { const f32x4 a = *(const f32x4*)p, b = *(const f32x4*)(p + 4); o[0] = a.x; o[1] = a.y; o[2] = a.z; o[3] = a.w; o[4] = b.x; o[5] = b.y; o[6] = b.z; o[7] = b.w; }
__device__ __forceinline__ float sum8lanes(float v) { v += __shfl_xor(v, 1); v += __shfl_xor(v, 2); v += __shfl_xor(v, 4); return v; }
__device__ __forceinline__ void p_combine(Frame& F, int l) {
    const int gw = F.vcu * NWAVES + F.wave, NGW = F.G * NWAVES; const int lane = F.lane; const int c = lane * 8;
    const bf16* PROJ = (const bf16*)(F.ws + WS_PROJ); const bf16* DEC = (const bf16*)(F.ws + WS_DEC); const bf16* LRU = (const bf16*)(F.ws + WS_LRU); bf16* CAT = (bf16*)(F.ws + WS_XN);
    float lg[8], lb[8], ka[8], rk[8];
    ld8f(F.in[I_RW_LNXG] + l * 512 + c, lg); ld8f(F.in[I_RW_LNXB] + l * 512 + c, lb); ld8f(F.in[I_RW_KA] + l * 512 + c, ka); ld8f(F.in[I_RW_RK] + l * 512 + c, rk);
    for (int r = gw; r < M; r += NGW) {
        const bf16* pr = PROJ + (size_t)r * PIN; const bf16* dr = DEC + (size_t)r * NDEC; const bf16* lr = LRU + (size_t)r * 2048;
        float y0[8], y1[8], a0[8], a1[8], gg[8], rr[8], kk[8], vv[8], o[8];
        ld8(dr + c, y0); ld8(dr + 512 + c, y1); ld8(dr + 1024 + c, a0); ld8(dr + 1536 + c, a1); ld8(dr + 2048 + c, gg);
        ld8(pr + C_R + c, rr); ld8(pr + C_K + c, kk); ld8(pr + C_V + c, vv);
        float s = 0.f, bs = 0.f;
#pragma unroll
        for (int e = 0; e < 8; ++e) { o[e] = y0[e] + y1[e]; s += o[e]; bs += rr[e] * kk[e] * (2.0f + (a0[e] + a1[e] - 2.0f) * ka[e]) * rk[e]; }
        const float mu = sum8lanes(s) * (1.f / 64.f); const float bonus = sum8lanes(bs); float q = 0.f;
#pragma unroll
        for (int e = 0; e < 8; ++e) { o[e] -= mu; q += o[e] * o[e]; }
        const float rstd = 1.0f / sqrtf(sum8lanes(q) * (1.f / 64.f) + 64e-5f);
        float ya[8];
#pragma unroll
        for (int e = 0; e < 8; ++e) ya[e] = (o[e] * rstd * lg[e] + lb[e] + bonus * vv[e]) * gg[e];
        v4u w; w.x = pk2(ya[0], ya[1]); w.y = pk2(ya[2], ya[3]); w.z = pk2(ya[4], ya[5]); w.w = pk2(ya[6], ya[7]);
        *(GAS v4u*)(CAT + (size_t)r * D + c) = w;
#if MK_NAIVE_SCAN
        float h0[8], h1[8], gb[8];
        ld8(lr + 512 + c, h0); ld8(lr + 1024 + 512 + c, h1); ld8(pr + C_GB + c, gb);
#pragma unroll
        for (int e = 0; e < 8; ++e) ya[e] = bf2f((bf16)f2bf(h0[e] + h1[e])) * gelu_tanh(gb[e]);
        w.x = pk2(ya[0], ya[1]); w.y = pk2(ya[2], ya[3]); w.z = pk2(ya[4], ya[5]); w.w = pk2(ya[6], ya[7]);
        *(GAS v4u*)(CAT + (size_t)r * D + 512 + c) = w;
#endif
    }
}

namespace wkv {
typedef short bf16x8 __attribute__((ext_vector_type(8)));
constexpr int SL_WP = 0, SL_RP = 2304, SL_BKT = 4608, SL_GP = 9728, SL_UU = 11008, SL_GC = 12288, SL_VS = 12544, SLOT_BYTES = 14592;
constexpr int SCR_OFF = 8 * SLOT_BYTES, SCR_BYTES = 9216;
constexpr int SC_XA = 0, SC_XB = 2304, SC_XK = 4608, SC_XR = 6912, SC_LAB = 2304, SC_LAK = 3328, SC_T = 4352, SC_RN = 4096;
static_assert(SCR_OFF + 4 * SCR_BYTES <= 155648, "scan LDS map");
struct UnitInfo { int lat, s, d, h, T, row0, N; };
__device__ __forceinline__ UnitInfo unit_info(int u) { UnitInfo q; q.lat = u < 64; const int t = q.lat ? u : u - 64; q.s = t >> 4; q.d = (t >> 3) & 1; q.h = t & 7; q.T = q.lat ? DSEQ : SEQ; q.row0 = q.lat ? NCTXROWS + q.s * DSEQ : q.s * SEQ; q.N = q.T / 16; return q; }
__device__ __forceinline__ int tok_row(const UnitInfo& q, int p) { return q.row0 + (q.d ? q.T - 1 - p : p); }
__device__ __forceinline__ bf16x8 mk8(unsigned a, unsigned b, unsigned c, unsigned d) { const v4u w = {a, b, c, d}; return __builtin_bit_cast(bf16x8, w); }

struct Raw { unsigned short k[16], r[16], a[16], w[16], v[16]; };
__device__ __forceinline__ void prep_load(Raw& R, const bf16* PROJ, const bf16* DEC, const UnitInfo& q, int c, int lane) {
#pragma unroll
    for (int t = 0; t < 16; ++t) { const size_t row = (size_t)tok_row(q, 16 * c + t); const bf16* pr = PROJ + row * PIN + q.h * 64 + lane; const bf16* dr = DEC + row * NDEC + q.d * 512 + q.h * 64 + lane;
        R.k[t] = pr[C_K]; R.r[t] = pr[C_R]; R.v[t] = pr[C_V]; R.w[t] = dr[0]; R.a[t] = dr[1024]; }
}
template <class Reload>
__device__ __forceinline__ void prep_chunk(Raw& R, LAS unsigned char* sl, LAS unsigned char* scr, float kkw, float kaw, int lane, Reload reload) {
    const int g = lane >> 4, c15 = lane & 15;
    const int pj = (lane & 32) + 8 * ((lane >> 2) & 3) + 4 * ((lane >> 4) & 1) + (lane & 3);
    { v4u v0, v1; v0.x = R.v[0] | ((unsigned)R.v[1] << 16); v0.y = R.v[2] | ((unsigned)R.v[3] << 16); v0.z = R.v[4] | ((unsigned)R.v[5] << 16); v0.w = R.v[6] | ((unsigned)R.v[7] << 16);
      v1.x = R.v[8] | ((unsigned)R.v[9] << 16); v1.y = R.v[10] | ((unsigned)R.v[11] << 16); v1.z = R.v[12] | ((unsigned)R.v[13] << 16); v1.w = R.v[14] | ((unsigned)R.v[15] << 16);
      *(LAS v4u*)(sl + SL_VS + lane * 32) = v0; *(LAS v4u*)(sl + SL_VS + lane * 32 + 16) = v1; }
    LAS float* NRM = (LAS float*)(scr); float tot = 0.f;
#pragma unroll
    for (int t = 0; t < 16; ++t) { const float x = bf2f(R.k[t]) * kkw; NRM[t * 64 + lane] = x * x; tot += bf2f(R.w[t]); }
    const float gC = fexp(tot);
    LDS_WAIT();
    { float s = 0.f; const LAS f32x4* p = (const LAS f32x4*)(NRM + (lane >> 2) * 64 + (lane & 3) * 16);
#pragma unroll
      for (int e = 0; e < 4; ++e) { const f32x4 x = p[e]; s += (x.x + x.y) + (x.z + x.w); }
      s += __shfl_xor(s, 1); s += __shfl_xor(s, 2);
      LDS_WAIT();
      if ((lane & 3) == 0) ((LAS float*)(scr + SC_RN))[lane >> 2] = 1.0f / sqrtf(s + 1e-12f); }
    LDS_WAIT();
    float rn[16];
    { const LAS f32x4* p = (const LAS f32x4*)(scr + SC_RN);
#pragma unroll
      for (int e = 0; e < 4; ++e) { const f32x4 x = p[e]; rn[4 * e] = x.x; rn[4 * e + 1] = x.y; rn[4 * e + 2] = x.z; rn[4 * e + 3] = x.w; } }
    LDS_WAIT();
    float At[16]; unsigned bhp[8], khp[8]; float cum = 0.f, eprev = 1.f, bprev = 0.f, kprev = 0.f;
    LAS bf16* XA = (LAS bf16*)(scr + SC_XA); LAS bf16* XB = (LAS bf16*)(scr + SC_XB); LAS bf16* XK = (LAS bf16*)(scr + SC_XK); LAS bf16* XR = (LAS bf16*)(scr + SC_XR);
    LAS bf16* RP = (LAS bf16*)(sl + SL_RP);
#pragma unroll
    for (int t = 0; t < 16; ++t) {
        const float kj = bf2f(R.k[t]), rj = bf2f(R.r[t]), aj = bf2f(R.a[t]); cum += bf2f(R.w[t]);
        const float ep = fexp(cum), em = __builtin_amdgcn_rcpf(ep); const float kn = kj * kkw * rn[t];
        At[t] = kn * eprev; const float bt = kn * aj * em, kt = kj * (1.0f + (aj - 1.0f) * kaw) * em, rt = rj * ep; eprev = ep;
        XA[t * 72 + lane] = (bf16)f2bf(At[t]); XB[t * 72 + lane] = (bf16)f2bf(bt); XK[t * 72 + lane] = (bf16)f2bf(kt); const bf16 rb = (bf16)f2bf(rt); XR[t * 72 + lane] = rb; RP[t * 72 + pj] = rb;
        if (t & 1) { bhp[t >> 1] = pk2(bprev * gC, bt * gC); khp[t >> 1] = pk2(kprev * gC, kt * gC); } else { bprev = bt; kprev = kt; }
    }
    reload(R);
    LDS_WAIT();
    f32x4 lab = {0.f, 0.f, 0.f, 0.f}, lak = lab, urb = lab, urk = lab;
#pragma unroll
    for (int ks = 0; ks < 2; ++ks) { const int off = c15 * 144 + ks * 64 + g * 16;
        const bf16x8 fa = *(const LAS bf16x8*)(scr + SC_XA + off), fb = *(const LAS bf16x8*)(scr + SC_XB + off), fk = *(const LAS bf16x8*)(scr + SC_XK + off), fr = *(const LAS bf16x8*)(scr + SC_XR + off);
        lab = __builtin_amdgcn_mfma_f32_16x16x32_bf16(fa, fb, lab, 0, 0, 0); lak = __builtin_amdgcn_mfma_f32_16x16x32_bf16(fa, fk, lak, 0, 0, 0);
        urb = __builtin_amdgcn_mfma_f32_16x16x32_bf16(fr, fb, urb, 0, 0, 0); urk = __builtin_amdgcn_mfma_f32_16x16x32_bf16(fr, fk, urk, 0, 0, 0); }
    LDS_WAIT();
    { LAS float* LAB = (LAS float*)(scr + SC_LAB); LAS float* LAK = (LAS float*)(scr + SC_LAK); LAS bf16* UU = (LAS bf16*)(sl + SL_UU);
      const int us = 8 * (c15 >> 2) + (c15 & 3);
#pragma unroll
      for (int e = 0; e < 4; ++e) { const int t = 4 * g + e; LAB[t * 16 + c15] = c15 < t ? lab[e] : 0.f; LAK[t * 16 + c15] = c15 < t ? lak[e] : 0.f;
          UU[t * 40 + us] = (bf16)f2bf(c15 <= t ? urb[e] : 0.f); UU[t * 40 + us + 4] = (bf16)f2bf(c15 <= t ? urk[e] : 0.f); } }
    LDS_WAIT();
    { const LAS f32x4* LAB4 = (const LAS f32x4*)(scr + SC_LAB); float Tc[16];
#pragma unroll
      for (int t = 0; t < 16; ++t) { float acc = (t == c15) ? 1.f : 0.f;
#pragma unroll
          for (int s4 = 0; s4 < (t + 3) / 4; ++s4) { const f32x4 x = LAB4[t * 4 + s4];
#pragma unroll
              for (int e = 0; e < 4; ++e) if (4 * s4 + e < t) acc -= x[e] * Tc[4 * s4 + e]; }
          Tc[t] = acc; }
      LAS float* TT = (LAS float*)(scr + SC_T);
      if (lane < 16) {
#pragma unroll
          for (int t = 0; t < 16; ++t) TT[t * 16 + lane] = Tc[t]; } }
    LDS_WAIT();
    { const int t = lane >> 2, sg = lane & 3; const LAS float* TT = (const LAS float*)(scr + SC_T) + t * 16; const LAS f32x4* LAK4 = (const LAS f32x4*)(scr + SC_LAK) + sg;
      f32x4 gacc = {0.f, 0.f, 0.f, 0.f};
#pragma unroll
      for (int u = 0; u < 16; ++u) gacc -= TT[u] * LAK4[u * 4];
      v4u w; w.x = pk2(gacc.x, gacc.y); w.y = pk2(gacc.z, gacc.w); w.z = 0u; w.w = 0u;
      *(LAS v4u*)(sl + SL_GP + t * 80 + sg * 16) = w; }
    { const LAS f32x4* T4 = (const LAS f32x4*)(scr + SC_T); LAS bf16* WP = (LAS bf16*)(sl + SL_WP);
#pragma unroll
      for (int t = 0; t < 16; ++t) { float acc = 0.f;
#pragma unroll
          for (int s4 = 0; s4 < t / 4 + 1; ++s4) { const f32x4 x = T4[t * 4 + s4];
#pragma unroll
              for (int e = 0; e < 4; ++e) if (4 * s4 + e <= t) acc += x[e] * At[4 * s4 + e]; }
          WP[t * 72 + pj] = (bf16)f2bf(-acc); } }
    {
#pragma unroll
      for (int gg = 0; gg < 4; ++gg) { v4u w; w.x = bhp[2 * gg]; w.y = bhp[2 * gg + 1]; w.z = khp[2 * gg]; w.w = khp[2 * gg + 1]; *(LAS v4u*)(sl + SL_BKT + lane * 80 + gg * 16) = w; }
      ((LAS float*)(sl + SL_GC))[lane] = gC; }
}
__device__ __forceinline__ void seq_chunk(f32x4 (&st)[4], const LAS unsigned char* sl, bf16* DEC, const UnitInfo& q, int c, int slice, int lane) {
    const int g = lane >> 4, c15 = lane & 15;
    const bf16x8 stb0 = mk8(pk2(st[0].x, st[0].y), pk2(st[0].z, st[0].w), pk2(st[1].x, st[1].y), pk2(st[1].z, st[1].w));
    const bf16x8 stb1 = mk8(pk2(st[2].x, st[2].y), pk2(st[2].z, st[2].w), pk2(st[3].x, st[3].y), pk2(st[3].z, st[3].w));
    const int ao = c15 * 144 + g * 16, so = c15 * 80 + g * 16;
    const bf16x8 wp0 = *(const LAS bf16x8*)(sl + SL_WP + ao), wp1 = *(const LAS bf16x8*)(sl + SL_WP + ao + 64), rp0 = *(const LAS bf16x8*)(sl + SL_RP + ao), rp1 = *(const LAS bf16x8*)(sl + SL_RP + ao + 64);
    const bf16x8 gp = *(const LAS bf16x8*)(sl + SL_GP + so), uu = *(const LAS bf16x8*)(sl + SL_UU + so);
    const v2u vv = *(const LAS v2u*)(sl + SL_VS + (16 * slice + c15) * 32 + g * 8);
    const bf16x8 vb = mk8(vv.x, vv.y, vv.x, vv.y);
    f32x4 D = {0.f, 0.f, 0.f, 0.f};
    D = __builtin_amdgcn_mfma_f32_16x16x32_bf16(gp, vb, D, 0, 0, 0); D = __builtin_amdgcn_mfma_f32_16x16x32_bf16(wp0, stb0, D, 0, 0, 0); D = __builtin_amdgcn_mfma_f32_16x16x32_bf16(wp1, stb1, D, 0, 0, 0);
    const bf16x8 dv = mk8(pk2(D.x, D.y), pk2(D.z, D.w), vv.x, vv.y);
    f32x4 Y = {0.f, 0.f, 0.f, 0.f};
    Y = __builtin_amdgcn_mfma_f32_16x16x32_bf16(rp0, stb0, Y, 0, 0, 0); Y = __builtin_amdgcn_mfma_f32_16x16x32_bf16(rp1, stb1, Y, 0, 0, 0); Y = __builtin_amdgcn_mfma_f32_16x16x32_bf16(uu, dv, Y, 0, 0, 0);
#pragma unroll
    for (int jt = 0; jt < 4; ++jt) { const f32x4 gc = *(const LAS f32x4*)(sl + SL_GC + (16 * jt + 4 * g) * 4); const bf16x8 bk = *(const LAS bf16x8*)(sl + SL_BKT + (16 * jt + c15) * 80 + g * 16);
        st[jt] = __builtin_amdgcn_mfma_f32_16x16x32_bf16(bk, dv, st[jt] * gc, 0, 0, 0); }
    bf16* yp = DEC + q.d * 512 + q.h * 64 + 16 * slice + c15;
#pragma unroll
    for (int e = 0; e < 4; ++e) yp[(size_t)tok_row(q, 16 * c + 4 * g + e) * NDEC] = (bf16)f2bf(Y[e]);
}
__device__ __forceinline__ int wg_unit(int vcu, int k) { if (vcu < 64) return k == 0 ? vcu : -1; const int u = (vcu - 64) + 192 * k; return u < 512 ? 64 + u : -1; }
__device__ __forceinline__ void scan_phase(Frame& F, int l) {
    const int lane = F.lane, wave = F.wave; const bf16* PROJ = (const bf16*)(F.ws + WS_PROJ); bf16* DEC = (bf16*)(F.ws + WS_DEC);
    int nun = 0; while (nun < 3 && wg_unit(F.vcu, nun) >= 0) ++nun;
    const int cpu = F.vcu < 64 ? 128 : 16;
    const int total = nun * cpu, rounds = total / 4 + 1;
    if (wave >= 4) {
        const int pw = wave - 4; LAS unsigned char* scr = F.lds + SCR_OFF + pw * SCR_BYTES;
        Raw R; UnitInfo q = unit_info(wg_unit(F.vcu, 0));
        float kkw = F.in[I_RW_KK][l * 512 + q.h * 64 + lane], kaw = F.in[I_RW_KA][l * 512 + q.h * 64 + lane];
        if (pw < total) prep_load(R, PROJ, DEC, q, pw, lane);
        for (int r = 0; r < rounds; ++r) {
            const int gc = 4 * r + pw, gcn = gc + 4;
            UnitInfo qn = q; float kkwn = kkw, kawn = kaw;
            if (gcn < total && gcn / cpu != gc / cpu) { qn = unit_info(wg_unit(F.vcu, gcn / cpu)); kkwn = F.in[I_RW_KK][l * 512 + qn.h * 64 + lane]; kawn = F.in[I_RW_KA][l * 512 + qn.h * 64 + lane]; }
            if (gc < total) prep_chunk(R, F.lds + (gc & 7) * SLOT_BYTES, scr, kkw, kaw, lane, [&](Raw& RR) { if (gcn < total) prep_load(RR, PROJ, DEC, qn, gcn % cpu, lane); });
            q = qn; kkw = kkwn; kaw = kawn;
            LDS_WAIT(); __builtin_amdgcn_s_barrier(); asm volatile("" ::: "memory");
        }
    } else {
        f32x4 st[4]; UnitInfo q = unit_info(wg_unit(F.vcu, 0));
        for (int r = 0; r < rounds; ++r) {
            if (r > 0) {
                for (int k4 = 0; k4 < 4; ++k4) { const int gc = 4 * (r - 1) + k4, c = gc % cpu;
                    if (c == 0) { q = unit_info(wg_unit(F.vcu, gc / cpu));
                        if (q.lat) { const float* sp = F.in[I_SRWKV] + ((((size_t)q.s * 4 + l) * 2 + q.d) * 8 + q.h) * 4096 + (size_t)(16 * wave + (lane & 15)) * 64 + 4 * (lane >> 4);
#pragma unroll
                            for (int jt = 0; jt < 4; ++jt) st[jt] = *(const f32x4*)(sp + 16 * jt); }
                        else {
#pragma unroll
                            for (int jt = 0; jt < 4; ++jt) st[jt] = (f32x4){0.f, 0.f, 0.f, 0.f}; } }
                    seq_chunk(st, F.lds + (gc & 7) * SLOT_BYTES, DEC, q, c, wave, lane);
                    if (c == cpu - 1 && !q.lat) { float* op = F.out + O_SRWKV + ((((size_t)q.s * 4 + l) * 2 + q.d) * 8 + q.h) * 4096 + (size_t)(16 * wave + (lane & 15)) * 64 + 4 * (lane >> 4);
#pragma unroll
                        for (int jt = 0; jt < 4; ++jt) *(f32x4*)(op + 16 * jt) = st[jt]; }
                }
            }
            LDS_WAIT(); __builtin_amdgcn_s_barrier(); asm volatile("" ::: "memory");
        }
    }
}
}
constexpr size_t WS_LAGG = 2 * MiB;
__device__ __forceinline__ void lru_pass1(Frame& F, int task) {
    const int blk = task >> 4, d = (task >> 3) & 1, c = (task & 7) * 64 + F.lane;
    const bf16* LRU = (const bf16*)(F.ws + WS_LRU) + ((size_t)blk * 64 * 2 + d) * 1024 + c;
    float sla = 0.f, h = 0.f;
#pragma unroll 16
    for (int i = 0; i < 64; ++i) { const int t = d ? 63 - i : i; const float la = bf2f(LRU[(size_t)t * 2048]), u = bf2f(LRU[(size_t)t * 2048 + 512]); sla += la; h = fexp(la) * h + u; }
    float* A = (float*)(F.ws + WS_LAGG) + ((size_t)blk * 2 + d) * 1024 + c; A[0] = sla; A[512] = h;
}
__device__ __forceinline__ void lru_pass2(Frame& F, int l, int task) {
    const int blk = task >> 3, c = (task & 7) * 64 + F.lane;
    const bool lat = blk >= 128; const int s = lat ? (blk - 128) >> 5 : blk >> 2, bi = lat ? (blk - 128) & 31 : blk & 3, nb = lat ? 32 : 4, b0 = blk - bi;
    const float* AG = (const float*)(F.ws + WS_LAGG);
    const bf16* LRU = (const bf16*)(F.ws + WS_LRU) + (size_t)blk * 64 * 2048 + c;
    const bf16* PROJ = (const bf16*)(F.ws + WS_PROJ) + (size_t)blk * 64 * PIN + C_GB + c; bf16* CAT = (bf16*)(F.ws + WS_XN) + (size_t)blk * 64 * D + 512 + c;
    float h1 = lat ? F.in[I_SLRU][(((size_t)s * 4 + l) * 2 + 1) * 512 + c] : 0.f;
    for (int b = nb - 1; b > bi; --b) { const float* a = AG + ((size_t)(b0 + b) * 2 + 1) * 1024 + c; h1 = fexp(a[0]) * h1 + a[512]; }
    float hb[64];
#pragma unroll
    for (int i = 0; i < 64; ++i) { const int t = 63 - i; const float la = bf2f(LRU[(size_t)t * 2048 + 1024]), u = bf2f(LRU[(size_t)t * 2048 + 1024 + 512]); h1 = fexp(la) * h1 + u; hb[t] = h1; }
    if (!lat && bi == 0) F.out[O_SLRU + (((size_t)s * 4 + l) * 2 + 1) * 512 + c] = h1;
    float h0 = lat ? F.in[I_SLRU][(((size_t)s * 4 + l) * 2 + 0) * 512 + c] : 0.f;
    for (int b = 0; b < bi; ++b) { const float* a = AG + ((size_t)(b0 + b) * 2 + 0) * 1024 + c; h0 = fexp(a[0]) * h0 + a[512]; }
#pragma unroll
    for (int t = 0; t < 64; ++t) { const float la = bf2f(LRU[(size_t)t * 2048]), u = bf2f(LRU[(size_t)t * 2048 + 512]); h0 = fexp(la) * h0 + u;
        const float gb = bf2f(PROJ[(size_t)t * PIN]); CAT[(size_t)t * D] = (bf16)f2bf((h0 + hb[t]) * gelu_tanh(gb)); }
    if (!lat && bi == nb - 1) F.out[O_SLRU + (((size_t)s * 4 + l) * 2 + 0) * 512 + c] = h0;
}

constexpr int PH_PER_LAYER = 10, PH_PRO = 3, N_PHASES = PH_PRO + DEPTH * PH_PER_LAYER;
__global__ void __launch_bounds__(NWAVES * 64, 2) mk_fwd(Args args) {
    extern __shared__ __attribute__((aligned(16))) unsigned char lds[];
    Frame F;
    F.lds = (LAS unsigned char*)lds;
    F.tid = threadIdx.x; F.lane = F.tid & 63; F.wave = __builtin_amdgcn_readfirstlane(F.tid >> 6);
    F.G = gridDim.x; { const int bx = blockIdx.x; F.vcu = (F.G % 8 == 0) ? (bx % 8) * (F.G / 8) + bx / 8 : bx; }
    F.in = args.in; F.out = args.out; F.ws = args.ws;
    const int vcu0 = F.vcu, G0 = F.G;
    volatile LAS unsigned* MISC = (volatile LAS unsigned*)(F.lds + MISC_OFF);
    for (int u = F.tid; u < (LDS_BYTES - LDSCTL_OFF) / 4; u += NWAVES * 64) ((LAS unsigned*)(F.lds + LDSCTL_OFF))[u] = 0u;
    __syncthreads();
    const int lo = args.ph_lo, hi = args.ph_hi;
    XcdBarrier bar; bar.bar = (unsigned*)(F.ws + WS_CTL) + CW_BAR; bar.x = 0; bar.st = nullptr;
    if (hi - lo > 1) bar = xcd_barrier_post((unsigned*)(F.ws + WS_CTL) + CW_BAR, MISC + 8);
    for (int ph = lo; ph < hi; ++ph) {
        { const float* const* in_ = args.in; float* out_ = args.out; unsigned char* ws_ = args.ws; int vcu_ = vcu0, G_ = G0; asm volatile("" : "+s"(out_), "+s"(ws_), "+s"(vcu_), "+s"(G_)); F.in = in_; F.out = out_; F.ws = ws_; F.vcu = vcu_; F.G = G_; }
        { int t_ = threadIdx.x; asm volatile("" : "+v"(t_)); F.tid = t_; F.lane = t_ & 63; F.wave = __builtin_amdgcn_readfirstlane(t_ >> 6); }
        bf16* XN = (bf16*)(F.ws + WS_XN); bf16* PROJ = (bf16*)(F.ws + WS_PROJ); bf16* DEC = (bf16*)(F.ws + WS_DEC); bf16* LRU = (bf16*)(F.ws + WS_LRU); bf16* AUX = LRU; bf16* ACT = PROJ; bf16* XC = XN;
        if (ph == 1000) {
            const bf16* src = (const bf16*)(F.ws + (MK_DBG_BUF == 0 ? WS_PROJ : MK_DBG_BUF == 1 ? WS_DEC : MK_DBG_BUF == 2 ? WS_LRU : WS_XN));
            const size_t gt = (size_t)(F.vcu * NWAVES + F.wave) * 64 + F.lane, NT = (size_t)F.G * NWAVES * 64;
            for (size_t i = gt; i < (size_t)16777216; i += NT) F.out[i] = bf2f(src[i]);
        } else
        if (ph == 0) { if (MK_EN & 1) p0_prologue(F); }
        else if (ph == 1) { if (MK_EN & 2) p1_modreduce(F); }
        else if (ph == 2) { if (MK_EN & 4) p_modnorm(F, 0, 0, true); }
        else {
            const int l = (ph - PH_PRO) / PH_PER_LAYER, s = (ph - PH_PRO) % PH_PER_LAYER;
            if (s == 0) { if (MK_EN & 8) {
                pg8::Gemm g{XN, wlayer(F, l, WL_IN), M, PIN, D, D, 0, 0}; pg8::StaticOrder S; S.init(M, PIN, F.G, (int)blockIdx.x);
                pg8::EpiProj E{PROJ, AUX};
                pg8::gemm_phase<pg8::EpiProj, pg8::StaticOrder, true, true>(F.lds + RING_OFF, g, S, E);
            } } else if (s == 1) { if (MK_EN & 16) {
                { pg8::Gemm g{AUX, wlayer(F, l, WL_AUX), M, NDEC, NAUX, NAUX, 0, 0}; pg8::StaticOrder S; S.init(M, NDEC, F.G, (int)blockIdx.x);
                  pg8::EpiDec E{DEC, F.in[I_RW_W0] + l * 1024, F.in[I_RW_A0] + l * 1024};
                  pg8::gemm_phase<pg8::EpiDec, pg8::StaticOrder, true, true>(F.lds + RING_OFF, g, S, E); }
                p_lruconv(F, l);
            } } else if (s == 2) { if (MK_EN & 32) {
                pg8::Gemm g{XC, wlayer(F, l, WL_LRU), M, NLRU, 256, 512, 256, 2}; pg8::StaticOrder S; S.init(M, NLRU, F.G, (int)blockIdx.x);
                pg8::EpiLru E{LRU, XC, F.in[I_LRU_GAB] + l * 1024, F.in[I_LRU_GXB] + l * 1024, (const float*)(F.ws + WS_SPT) + l * 1024};
                pg8::gemm_phase<pg8::EpiLru, pg8::StaticOrder, true, true>(F.lds + RING_OFF, g, S, E);
            } } else if (s == 3) { if (MK_EN & 64) {
#if MK_NAIVE_SCAN
                p_scan_naive(F, l);
#else
                wkv::scan_phase(F, l);
                if (F.vcu >= 64) { const int gw = (F.vcu - 64) * NWAVES + F.wave; for (int t = gw; t < 4096; t += 192 * NWAVES) lru_pass1(F, t); }
#endif
            } }
            else if (s == 4) { if (MK_EN & 128) {
#if !MK_NAIVE_SCAN
                { const int gw = F.vcu * NWAVES + F.wave; for (int t = gw; t < 2048; t += F.G * NWAVES) lru_pass2(F, l, t); }
#endif
                p_combine(F, l); } }
            else if (s == 5) { if (MK_EN & 256) {
                pg8::Gemm g{XN, wlayer(F, l, WL_OUT), M, D, D, D, 0, 0}; pg8::StaticOrder S; S.init(M, D, F.G, (int)blockIdx.x);
                pg8::EpiRes E{l == 0 ? F.in[I_XP] : F.out, l == 0 ? F.in[I_XS] : F.out + (size_t)NCTXROWS * D, F.out, modp(F, l, 0) + 2048};
                pg8::gemm_phase<pg8::EpiRes, pg8::StaticOrder, true, true>(F.lds + RING_OFF, g, S, E);
            } } else if (s == 6) { if (MK_EN & 512) p_modnorm(F, l, 1, false); }
            else if (s == 7) { if (MK_EN & 1024) {
                pg8::Gemm g{XN, wlayer(F, l, WL_UP), M, 2 * DFF, D, D, 0, 0}; pg8::StaticOrder S; S.init(M, 2 * DFF, F.G, (int)blockIdx.x);
                pg8::EpiFfn E{ACT, F.in[I_FCW] + (size_t)l * 3 * 5632, F.in[I_FCB] + (size_t)l * 5632, (PG8_LAS float*)(F.lds + XBUF_OFF)};
                pg8::gemm_phase<pg8::EpiFfn, pg8::StaticOrder, true, true>(F.lds + RING_OFF, g, S, E);
            } } else if (s == 8) { if (MK_EN & 2048) {
                pg8::Gemm g{ACT, wlayer(F, l, WL_DOWN), M, D, DFF, DFF, 0, 0}; pg8::StaticOrder S; S.init(M, D, F.G, (int)blockIdx.x);
                pg8::EpiRes E{F.out, F.out + (size_t)NCTXROWS * D, F.out, modp(F, l, 0) + 5120};
                pg8::gemm_phase<pg8::EpiRes, pg8::StaticOrder, true, true>(F.lds + RING_OFF, g, S, E);
            } } else { if (MK_EN & 4096) {
                if (l + 1 < DEPTH) p_modnorm(F, l + 1, 0, false); else p_finalnorm(F);
            } }
        }
        if (ph + 1 < hi) xcd_barrier(bar);
    }
}

extern "C" void kernel_launch(void* const* d_in, const int* in_sizes, int n_in, void* d_out, int out_size, void* d_ws, size_t ws_size, hipStream_t stream) {
    static int grid = 0;
    if (grid == 0) {
        if (n_in != N_IN || (size_t)out_size != OUT_TOTAL || ws_size < WS_END) { fprintf(stderr, "kernel_launch: unexpected shapes: n_in %d out %d ws %zu\n", n_in, out_size, ws_size); grid = -1; return; }
        int dev = 0, cus = 0;
        if (hipGetDevice(&dev) != hipSuccess || hipDeviceGetAttribute(&cus, hipDeviceAttributeMultiprocessorCount, dev) != hipSuccess) { grid = -1; return; }
        if (hipFuncSetAttribute((const void*)mk_fwd, hipFuncAttributeMaxDynamicSharedMemorySize, LDS_BYTES) != hipSuccess) { grid = -1; return; }
        (void)hipGetLastError();
        grid = cus;
    }
    if (grid < 0) return;
    (void)hipMemsetAsync((char*)d_ws + WS_CTL, 0, CTL_ZERO_BYTES, stream);
    Args a{};
    for (int i = 0; i < N_IN; ++i) a.in[i] = (const float*)d_in[i];
    a.out = (float*)d_out; a.ws = (unsigned char*)d_ws;
#if MK_ONE_LAUNCH
    a.ph_lo = 0; a.ph_hi = N_PHASES;
    hipLaunchKernelGGL(mk_fwd, dim3(grid), dim3(NWAVES * 64), LDS_BYTES, stream, a);
#else
    const int nph = MK_DBG_STOP ? MK_DBG_STOP : N_PHASES;
    for (int ph = 0; ph < nph; ++ph) { a.ph_lo = ph; a.ph_hi = ph + 1; hipLaunchKernelGGL(mk_fwd, dim3(grid), dim3(NWAVES * 64), LDS_BYTES, stream, a); }
    if (MK_DBG_STOP) { a.ph_lo = 1000; a.ph_hi = 1001; hipLaunchKernelGGL(mk_fwd, dim3(grid), dim3(NWAVES * 64), LDS_BYTES, stream, a); }
#endif
}
```

```cpp
#include <hip/hip_runtime.h>
#include <cstdio>
#include <cstdint>
#define MK_ONE_LAUNCH 1
namespace pg8 {
#define PG8_LAS __attribute__((address_space(3)))
typedef unsigned short bf16_t;
typedef short bf16x8 __attribute__((ext_vector_type(8)));
typedef float f32x4 __attribute__((ext_vector_type(4)));
typedef unsigned u32x4 __attribute__((ext_vector_type(4)));
constexpr int BM = 256, BK = 64, HALF = 128, HTB = HALF * BK * 2  , STAGE_BYTES = 8 * HTB, NXCD = 8, WGM = 8;

__host__ __device__ __forceinline__ int lds_byte(int r, int c) { const int st = (r >> 4) * 2 + (c >> 5), rr = r & 15, cc = c & 31, ob = rr * 64 + cc * 2; return st * 1024 + (ob ^ (((ob >> 9) & 1) << 5)); }
__host__ __device__ __forceinline__ void stage_rc(int b, int& R, int& C) { const int st = b / 1024, sb = b % 1024, swz = sb ^ (((sb >> 9) & 1) << 5); R = (st >> 1) * 16 + swz / 64; C = (st & 1) * 32 + (swz % 64) / 2; }
__host__ __device__ __forceinline__ int perm32(int rho) { const int n = rho >> 4, i = rho & 15; return 8 * (i >> 2) + 4 * n + (i & 3); }

struct Unit { int pm, pn; };
struct Gemm { const bf16_t* A; const bf16_t* Bt; int M, N, K; int lda; int apn; int apsh; };

struct StaticOrder {
    int nM, nN, nwg, G, c;
    __host__ __device__ __forceinline__ void init(int M, int N, int G_, int c_) { nM = M / BM; nN = N / BM; nwg = nM * nN; G = G_; c = c_; }
    __host__ __device__ __forceinline__ bool next(int i, Unit& u) const {
        const long L = (long)i * G + c; if (L >= nwg) return false;
        int wgid = (int)L; { const int q = nwg / NXCD, r = nwg % NXCD, xcd = wgid % NXCD, off = wgid / NXCD; wgid = (xcd < r ? xcd * (q + 1) : r * (q + 1) + (xcd - r) * q) + off; }
        const int nig = WGM * nN, gid = wgid / nig, fm = gid * WGM, gsz = (nM - fm) < WGM ? (nM - fm) : WGM;
        u.pm = fm + ((wgid % nig) % gsz); u.pn = (wgid % nig) / gsz; return true;
    }
    __device__ __forceinline__ void a_ready(const Unit&) const {}
    __device__ __forceinline__ void done(const Unit&) const {}
};

typedef __bf16 bf16x2_hw __attribute__((ext_vector_type(2)));
typedef float f32x2_cv __attribute__((ext_vector_type(2)));
__device__ __forceinline__ unsigned cvt_pk_bf16(float lo, float hi) { const f32x2_cv v = {lo, hi}; return __builtin_bit_cast(unsigned, __builtin_convertvector(v, bf16x2_hw)); }
typedef float f32x2 __attribute__((ext_vector_type(2)));
__device__ __forceinline__ f32x2 gelu_pk(f32x2 v) {
    const f32x2 av = __builtin_elementwise_abs(v), d = av * 0.2316418882f + 1.0f;
    f32x2 t; t.x = __builtin_amdgcn_rcpf(d.x); t.y = __builtin_amdgcn_rcpf(d.y);
    f32x2 q = t * 0.5307027145f + (-0.7265760135f); q = q * t + 0.7107068705f; q = q * t + (-0.142248368f); q = q * t + 0.127414796f; q = q * t;
    const f32x2 s = (v * v) * (-0.72134752044f);
    f32x2 e; e.x = __builtin_amdgcn_exp2f(s.x); e.y = __builtin_amdgcn_exp2f(s.y);
    const f32x2 m = v * (q * e), r = v - m;
    f32x2 o; o.x = v.x < 0.f ? m.x : r.x; o.y = v.y < 0.f ? m.y : r.y; return o;
}

template <int ACT  > struct EpiBf16 {
    static constexpr bool PERM = true, AFTER_DRAIN = false; static_assert(ACT == 0 || ACT == 1, "EpiBf16: ACT is 0 (none) or 1 (gelu_pk)");
    bf16_t* O; int ldc; const float* bias; int split_cols; size_t split_stride; float scale0;
    __device__ __forceinline__ void operator()(const f32x4 (&acc)[2][2][4][2], const Unit& u, int wr, int wc, int fr, int fq) const {
        const int row0 = u.pm * BM + wr * 64 + fr; int colt = u.pn * BM; bf16_t* base = O;
        float sc = 1.f; if (split_cols) { const int t = colt / split_cols; base += (size_t)t * split_stride; colt -= t * split_cols; if (t == 0) sc = scale0; }
        const int col0 = colt + wc * 32 + 8 * fq, bcol0 = u.pn * BM + wc * 32 + 8 * fq;
        f32x4 bv[2][2];
#pragma unroll
        for (int bj = 0; bj < 2; ++bj)
#pragma unroll
            for (int n = 0; n < 2; ++n) bv[bj][n] = bias ? *(const f32x4*)(bias + bcol0 + bj * HALF + 4 * n) : (f32x4){0.f, 0.f, 0.f, 0.f};
#pragma unroll
        for (int ai = 0; ai < 2; ++ai)
#pragma unroll
            for (int m = 0; m < 4; ++m) { bf16_t* rowp = base + (size_t)(row0 + ai * HALF + m * 16) * ldc + col0;
#pragma unroll
                for (int bj = 0; bj < 2; ++bj) { f32x4 v0 = acc[ai][bj][m][0] + bv[bj][0], v1 = acc[ai][bj][m][1] + bv[bj][1];
                    if (ACT == 1) { f32x2 a = gelu_pk((f32x2){v0[0], v0[1]}), b = gelu_pk((f32x2){v0[2], v0[3]}), c = gelu_pk((f32x2){v1[0], v1[1]}), d = gelu_pk((f32x2){v1[2], v1[3]});
                        v0 = (f32x4){a.x, a.y, b.x, b.y}; v1 = (f32x4){c.x, c.y, d.x, d.y}; }
                    v0 = v0 * sc; v1 = v1 * sc; u32x4 w; w.x = cvt_pk_bf16(v0[0], v0[1]); w.y = cvt_pk_bf16(v0[2], v0[3]); w.z = cvt_pk_bf16(v1[0], v1[1]); w.w = cvt_pk_bf16(v1[2], v1[3]);
                    *(u32x4*)(rowp + bj * HALF) = w; } }
    }
};

template <class Epi, class Sched, bool ALIGN_EPI = false, bool SP2 = false>
__device__ __forceinline__ void gemm_phase(PG8_LAS unsigned char* lds, const Gemm g, const Sched& S, const Epi& E, int tid_in) {
    int tid_ = tid_in; asm volatile("" : "+v"(tid_));
    const int tid = tid_, wid = __builtin_amdgcn_readfirstlane(tid >> 6), lane = tid & 63, wr = wid >> 2, wc = wid & 3, fr = lane & 15, fq = lane >> 4;
    int K_ = g.K; asm volatile("" : "+s"(K_));
    const int K = K_, nt = K / BK; __builtin_assume(nt >= 2);
    unsigned voffA[2], voffB[2];
#pragma unroll
    for (int i = 0; i < 2; ++i) { int R, C; stage_rc(tid * 16 + i * 8192, R, C); const int Rb = Epi::PERM ? ((R & ~31) + perm32(R & 31)) : R;
        voffA[i] = (unsigned)(R * g.lda + C) * 2u; voffB[i] = (unsigned)(Rb * K + C) * 2u; }
    const size_t kstep = (size_t)(BK * 2);
    const size_t hstepA = (size_t)HALF * g.lda * 2, hstepB = (size_t)HALF * K * 2;
    const size_t tstepA = 2 * hstepA, tstepB = 2 * hstepB, apnb = (size_t)g.apn * 2;
    const unsigned ldsw = (unsigned)wid * 1024u;
    const int aoff = lds_byte(wr * 64 + fr, fq * 8), boff = lds_byte(wc * 32 + fr, fq * 8);
#define PG8_SA(b, h) (((b) * 2 + (h)) * HTB)
#define PG8_SB(b, h) ((4 + (b) * 2 + (h)) * HTB)
#define PG8_STAGE(bufoff, gbase, voff) do { _Pragma("unroll") for (int _i = 0; _i < 2; ++_i) \
        __builtin_amdgcn_global_load_lds((const unsigned*)((const char*)(gbase) + (voff)[_i]), (PG8_LAS unsigned*)(lds + (bufoff) + ldsw + _i * 8192), 16, 0, 0); } while (0)
#define PG8_LDA(dst, b, h) do { _Pragma("unroll") for (int m = 0; m < 4; ++m) _Pragma("unroll") for (int k = 0; k < 2; ++k) dst[m][k] = *(const PG8_LAS bf16x8*)(lds + PG8_SA(b, h) + aoff + m * 2048 + k * 1024); } while (0)
#define PG8_LDB(dst, b, h) do { _Pragma("unroll") for (int n = 0; n < 2; ++n) _Pragma("unroll") for (int k = 0; k < 2; ++k) dst[n][k] = *(const PG8_LAS bf16x8*)(lds + PG8_SB(b, h) + boff + n * 2048 + k * 1024); } while (0)
#define PG8_MMA(ai, bj, At, Bt) do { __builtin_amdgcn_s_setprio(1); _Pragma("unroll") for (int m = 0; m < 4; ++m) _Pragma("unroll") for (int n = 0; n < 2; ++n) _Pragma("unroll") for (int k = 0; k < 2; ++k) \
        acc[ai][bj][m][n] = __builtin_amdgcn_mfma_f32_16x16x32_bf16(Bt[n][k], At[m][k], acc[ai][bj][m][n], 0, 0, 0); __builtin_amdgcn_s_setprio(0); } while (0)
#define PG8_WAIT_V(n) asm volatile("s_waitcnt vmcnt(" #n ")" ::: "memory")
#define PG8_WAIT_L(n) asm volatile("s_waitcnt lgkmcnt(" #n ")" ::: "memory")
#define PG8_BAR __builtin_amdgcn_s_barrier()
#define PG8_SCHED __builtin_amdgcn_sched_barrier(0)
    Unit cur, nxt; int ui = 0;
    if (!S.next(0, cur)) return;
    f32x4 acc[2][2][4][2];
#pragma unroll
    for (int a = 0; a < 2; ++a)
#pragma unroll
        for (int b = 0; b < 2; ++b)
#pragma unroll
            for (int m = 0; m < 4; ++m)
#pragma unroll
                for (int n = 0; n < 2; ++n) acc[a][b][m][n] = (f32x4){0.f, 0.f, 0.f, 0.f};
    bf16x8 At[4][2], B0[2][2], B1[2][2];
    const char* cA = (const char*)g.A + (size_t)cur.pm * tstepA + (size_t)(cur.pn >> g.apsh) * apnb; const char* cB = (const char*)g.Bt + (size_t)cur.pn * tstepB;
    S.a_ready(cur);
    if constexpr (SP2) {
        PG8_STAGE(PG8_SB(0, 0), cB, voffB); PG8_STAGE(PG8_SB(0, 1), cB + hstepB, voffB); PG8_STAGE(PG8_SA(0, 0), cA, voffA); PG8_STAGE(PG8_SA(0, 1), cA + hstepA, voffA);
        if (wr == 1) PG8_BAR;
        PG8_WAIT_V(2); PG8_BAR;
        PG8_STAGE(PG8_SB(1, 0), cB + kstep, voffB); PG8_STAGE(PG8_SA(1, 0), cA + kstep, voffA); PG8_STAGE(PG8_SB(1, 1), cB + hstepB + kstep, voffB);
        PG8_WAIT_V(6); PG8_BAR;
    } else {
        PG8_STAGE(PG8_SB(0, 0), cB, voffB); PG8_STAGE(PG8_SA(0, 0), cA, voffA); PG8_STAGE(PG8_SB(0, 1), cB + hstepB, voffB); PG8_STAGE(PG8_SA(0, 1), cA + hstepA, voffA);
        if (wr == 1) PG8_BAR;
        PG8_WAIT_V(4); PG8_BAR;
        PG8_STAGE(PG8_SB(1, 0), cB + kstep, voffB); PG8_STAGE(PG8_SA(1, 0), cA + kstep, voffA); PG8_STAGE(PG8_SB(1, 1), cB + hstepB + kstep, voffB);
        PG8_WAIT_V(6); PG8_BAR;
    }
    for (;;) {
        const bool has_next = S.next(ui + 1, nxt);
        const char* nA = has_next ? (const char*)g.A + (size_t)nxt.pm * tstepA + (size_t)(nxt.pn >> g.apsh) * apnb : cA; const char* nB = has_next ? (const char*)g.Bt + (size_t)nxt.pn * tstepB : cB;
        for (int t = 0; t < nt; t += 2) {
            const bool last = (t == nt - 2);
            const char* a1 = cA + (size_t)(t + 1) * kstep;
            const char* a2 = last ? nA : cA + (size_t)(t + 2) * kstep; const char* b2 = last ? nB : cB + (size_t)(t + 2) * kstep;
            const char* a3 = a2 + kstep; const char* b3 = b2 + kstep;
            if (last && has_next) S.a_ready(nxt);
            if constexpr (SP2) {
            PG8_LDB(B0, 0, 0); PG8_LDB(B1, 0, 1); PG8_SCHED; PG8_LDA(At, 0, 0); PG8_STAGE(PG8_SA(1, 1), a1 + hstepA, voffA);
            PG8_WAIT_V(8); PG8_WAIT_L(0); PG8_BAR; PG8_MMA(0, 0, At, B0); PG8_MMA(0, 1, At, B1); PG8_BAR; PG8_SCHED;
            PG8_LDA(At, 0, 1); PG8_STAGE(PG8_SB(0, 0), b2, voffB); PG8_STAGE(PG8_SB(0, 1), b2 + hstepB, voffB); PG8_STAGE(PG8_SA(0, 0), a2, voffA);
            PG8_WAIT_V(8); PG8_WAIT_L(0); PG8_BAR; PG8_MMA(1, 0, At, B0); PG8_MMA(1, 1, At, B1); PG8_BAR; PG8_SCHED;
            PG8_LDB(B0, 1, 0); PG8_LDB(B1, 1, 1); PG8_SCHED; PG8_LDA(At, 1, 0); PG8_STAGE(PG8_SA(0, 1), a2 + hstepA, voffA);
            PG8_WAIT_V(8); PG8_WAIT_L(0); PG8_BAR; PG8_MMA(0, 0, At, B0); PG8_MMA(0, 1, At, B1); PG8_BAR; PG8_SCHED;
            PG8_LDA(At, 1, 1); PG8_STAGE(PG8_SB(1, 0), b3, voffB); PG8_STAGE(PG8_SB(1, 1), b3 + hstepB, voffB); PG8_STAGE(PG8_SA(1, 0), a3, voffA);
            PG8_WAIT_V(8); PG8_WAIT_L(0); PG8_BAR; PG8_MMA(1, 0, At, B0); PG8_MMA(1, 1, At, B1); PG8_BAR; PG8_SCHED;
            } else {
            PG8_LDB(B0, 0, 0); PG8_SCHED; PG8_LDA(At, 0, 0); PG8_STAGE(PG8_SA(1, 1), a1 + hstepA, voffA);
            PG8_WAIT_L(8); PG8_BAR; PG8_WAIT_L(0); PG8_MMA(0, 0, At, B0); PG8_BAR; PG8_SCHED;
            PG8_LDB(B1, 0, 1); PG8_STAGE(PG8_SB(0, 0), b2, voffB);
            PG8_BAR; PG8_WAIT_L(0); PG8_MMA(0, 1, At, B1); PG8_BAR;
            PG8_LDA(At, 0, 1); PG8_STAGE(PG8_SA(0, 0), a2, voffA);
            PG8_BAR; PG8_WAIT_L(0); PG8_MMA(1, 0, At, B0); PG8_BAR; PG8_SCHED;
            PG8_STAGE(PG8_SB(0, 1), b2 + hstepB, voffB);
            PG8_WAIT_V(6); PG8_BAR; PG8_MMA(1, 1, At, B1); PG8_BAR;
            PG8_LDB(B0, 1, 0); PG8_SCHED; PG8_LDA(At, 1, 0); PG8_STAGE(PG8_SA(0, 1), a2 + hstepA, voffA);
            PG8_WAIT_L(8); PG8_BAR; PG8_WAIT_L(0); PG8_MMA(0, 0, At, B0); PG8_BAR; PG8_SCHED;
            PG8_LDB(B1, 1, 1); PG8_STAGE(PG8_SB(1, 0), b3, voffB);
            PG8_BAR; PG8_WAIT_L(0); PG8_MMA(0, 1, At, B1); PG8_BAR;
            PG8_LDA(At, 1, 1); PG8_STAGE(PG8_SA(1, 0), a3, voffA);
            PG8_BAR; PG8_WAIT_L(0); PG8_MMA(1, 0, At, B0); PG8_BAR; PG8_SCHED;
            PG8_STAGE(PG8_SB(1, 1), b3 + hstepB, voffB);
            PG8_WAIT_V(6); PG8_BAR; PG8_MMA(1, 1, At, B1); PG8_BAR;
            }
        }
        if constexpr (ALIGN_EPI) { if (wr == 0) PG8_BAR; }
        if constexpr (!Epi::AFTER_DRAIN) { E(acc, cur, wr, wc, fr, fq); S.done(cur); }
        if (!has_next) break;
#pragma unroll
        for (int a = 0; a < 2; ++a)
#pragma unroll
            for (int b = 0; b < 2; ++b)
#pragma unroll
                for (int m = 0; m < 4; ++m)
#pragma unroll
                    for (int n = 0; n < 2; ++n) acc[a][b][m][n] = (f32x4){0.f, 0.f, 0.f, 0.f};
        cur = nxt; cA = nA; cB = nB; ++ui;
        if constexpr (ALIGN_EPI) { if (wr == 1) PG8_BAR; }
    }
    PG8_WAIT_V(0);
    if constexpr (!ALIGN_EPI) { if (wr == 0) PG8_BAR; }
    PG8_BAR;
    if constexpr (Epi::AFTER_DRAIN) { E.fused(acc, cur, wr, wc, fr, fq, lds, wid, lane); S.done(cur); }
#undef PG8_SA
#undef PG8_SB
#undef PG8_STAGE
#undef PG8_LDA
#undef PG8_LDB
#undef PG8_MMA
#undef PG8_WAIT_V
#undef PG8_WAIT_L
#undef PG8_BAR
#undef PG8_SCHED
}
}

#ifndef MK_EN
#define MK_EN 0xFFFF
#endif
#ifndef MK_DBG_STOP
#define MK_DBG_STOP 0
#endif
#ifndef MK_DBG_BUF
#define MK_DBG_BUF 0
#endif
#ifndef MK_NAIVE_SCAN
#define MK_NAIVE_SCAN 0
#endif
#ifndef MK_DUP
#define MK_DUP 0
#endif
#ifndef MK_DRYSCAN
#define MK_DRYSCAN 0
#endif
#ifndef MK_TSEL
#define MK_TSEL 0
#endif
#ifndef MK_BCLS
#define MK_BCLS -1
#endif
#ifndef MK_TBLK
#define MK_TBLK 0
#endif
#ifndef MK_PREPPRIO
#define MK_PREPPRIO 0
#endif
#ifndef MK_SEQPRIO
#define MK_SEQPRIO 0
#endif
#ifndef MK_EARLYWB
#define MK_EARLYWB 0
#endif
#ifndef MK_WTSEL
#define MK_WTSEL 0
#endif
#ifndef MK_WT
#define MK_WT 1
#endif
#ifndef MK_TMUL
#define MK_TMUL 4
#endif
#ifndef MK_PSEG
#define MK_PSEG 0
#endif
#ifndef MK_SP2
#define MK_SP2 true
#endif
#ifndef MK_ONE_LAUNCH
#define MK_ONE_LAUNCH 0
#endif
#define GAS __attribute__((address_space(1)))
#define LAS __attribute__((address_space(3)))
typedef unsigned short bf16;
typedef unsigned v4u __attribute__((ext_vector_type(4)));
typedef unsigned v2u __attribute__((ext_vector_type(2)));
typedef float f32x4 __attribute__((ext_vector_type(4)));
typedef float f32x2 __attribute__((ext_vector_type(2)));
#define RLX_AGENT __ATOMIC_RELAXED, __HIP_MEMORY_SCOPE_AGENT
#define LDS_WAIT() asm volatile("s_waitcnt lgkmcnt(0)" ::: "memory")
#define VM_WAIT() asm volatile("s_waitcnt vmcnt(0)" ::: "memory")

constexpr int NWAVES = 8;
constexpr int D = 1024, M = 16384, NCTXROWS = 8192, DEPTH = 4, SEQ = 256, DSEQ = 2048, NB = 32, NDB = 4;
constexpr int PIN = 2816, DFF = 2816, NDEC = 2560, NAUX = 256, NLRU = 2048;
constexpr int C_R = 0, C_K = 512, C_V = 1024, C_XW = 1536, C_XB = 1792, C_GB = 2304;
constexpr float DECAY_SCALE = 0.6065306597126334f;
enum { I_XP = 0, I_XS, I_SRWKV, I_SLRU, I_C, I_CCTX, I_LN1G, I_WMOD, I_BMOD, I_WIN, I_RW_W0, I_RW_WUP, I_RW_A0, I_RW_AUP, I_RW_GUP, I_RW_KK, I_RW_KA, I_RW_RK,
       I_RW_LNXG, I_RW_LNXB, I_LRU_CW, I_LRU_CB, I_LRU_GAW, I_LRU_GAB, I_LRU_GXW, I_LRU_GXB, I_LRU_LAM, I_WOUT, I_LN2G, I_WUP, I_FCW, I_FCB, I_WDOWN, I_LNFG, N_IN };
constexpr size_t O_Y = 0, O_SRWKV = 16777216, O_SLRU = 16777216 + 8388608, OUT_TOTAL = 16777216 + 8388608 + 131072;
constexpr size_t MiB = 1u << 20;
constexpr size_t WS_CTL = 0, CTL_ZERO_BYTES = 128 * 1024;
constexpr size_t WS_MOD = 1 * MiB;
constexpr size_t WS_SPT = 1 * MiB + 512 * 1024;
constexpr size_t WS_MODP = 2 * MiB;
constexpr size_t WS_BIAS = 4 * MiB + MiB / 2;
constexpr size_t BIAS_UP_OFF = 4 * 5 * 2816;
constexpr size_t BIAS_QSTRIDE = 4 * 5 * (2816 + 5632);
constexpr size_t WS_RSS = 7 * MiB + MiB / 2;
constexpr size_t WS_W = 8 * MiB;
constexpr size_t WL_STRIDE = 26 * MiB + MiB / 4, WL_IN = 0, WL_OUT = 5 * MiB + MiB / 2, WL_UP = WL_OUT + 2 * MiB, WL_DOWN = WL_UP + 11 * MiB, WL_AUX = WL_DOWN + 5 * MiB + MiB / 2, WL_LRU = WL_AUX + MiB + MiB / 4;
static_assert(WL_LRU + 1 * MiB == WL_STRIDE, "weight map");
constexpr size_t WS_XN = WS_W + 4 * WL_STRIDE;
constexpr size_t WS_PROJ = WS_XN + 32 * MiB;
constexpr size_t WS_DEC = WS_PROJ + 88 * MiB;
constexpr size_t WS_LRU = WS_DEC + 80 * MiB;
constexpr size_t WS_BON = WS_CTL + 512 * 1024;
constexpr size_t WS_END = WS_LRU + 64 * MiB;
static_assert(WS_END == 377 * MiB, "ws map");
constexpr int CW_BAR = 4096;
constexpr int CW_FIN = 16384;
constexpr int CW_SUB = 8192;

__device__ __forceinline__ unsigned f2bf(float f) { unsigned u = __builtin_bit_cast(unsigned, f); return (u + 0x7fffu + ((u >> 16) & 1u)) >> 16; }
__device__ __forceinline__ unsigned pk2(float lo, float hi) { return pg8::cvt_pk_bf16(lo, hi); }
#if MK_WT
__device__ __forceinline__ void st16_wt(void* p, v4u v) { asm volatile("global_store_dwordx4 %0, %1, off sc1\n\ts_nop 1" :: "v"((GAS void*)p), "v"(v)); }
#else
__device__ __forceinline__ void st16_wt(void* p, v4u v) { *(GAS v4u*)p = v; }
#endif
__device__ __forceinline__ float bflo(unsigned w) { return __builtin_bit_cast(float, w << 16); }
__device__ __forceinline__ float bfhi(unsigned w) { return __builtin_bit_cast(float, w & 0xffff0000u); }
__device__ __forceinline__ float bf2f(bf16 h) { return __builtin_bit_cast(float, (unsigned)h << 16); }
__device__ __forceinline__ float fsigmoid(float x) { return __builtin_amdgcn_rcpf(1.0f + __builtin_amdgcn_exp2f(-1.4426950409f * x)); }
__device__ __forceinline__ float ftanh(float x) { return 2.0f * fsigmoid(2.0f * x) - 1.0f; }
__device__ __forceinline__ float gelu_tanh(float x) { const float z = 0.7978845608f * (x + 0.044715f * x * x * x); return x * fsigmoid(2.0f * z); }
__device__ __forceinline__ float fexp(float x) { return __builtin_amdgcn_exp2f(1.4426950409f * x); }
__device__ __forceinline__ float wave_sum(float v) {
#pragma unroll
    for (int o = 1; o < 64; o <<= 1) v += __shfl_xor(v, o);
    return v;
}

#define XB_TMO      128
#define XB_XCNT(j)  (256  + 64 * (j))
#define XB_XSUB(j)  (1280 + 64 * (j))
#define XB_XGEN(j)  (2304 + 64 * (j))
#define XB_TOP      3328
#define XB_TOPGEN   3392
#define XCD_BAR_WORDS 3456
#define XB_SPIN_CAP (1u << 20)
__device__ __forceinline__ unsigned xb_ld(unsigned* p)              { return __hip_atomic_load(p, __ATOMIC_RELAXED, __HIP_MEMORY_SCOPE_AGENT); }
__device__ __forceinline__ unsigned xb_add(unsigned* p, unsigned v) { return __hip_atomic_fetch_add(p, v, __ATOMIC_RELAXED, __HIP_MEMORY_SCOPE_AGENT); }
__device__ __forceinline__ unsigned xb_xcc_id() { return (unsigned)__builtin_amdgcn_s_getreg((3 << 11) | 20) & 0xFu; }
#define XB_SPIN(cond, bar) do { unsigned _sp = 0; while (cond) { __builtin_amdgcn_s_sleep(1); \
    if ((++_sp & 255u) == 0u) { if (xb_ld(&(bar)[XB_TMO])) break; if (_sp > XB_SPIN_CAP) { atomicAdd(&(bar)[XB_TMO], 1u); break; } } } } while (0)
struct XcdBarrier { unsigned* bar; unsigned x; volatile LAS unsigned* st; };
__device__ __forceinline__ XcdBarrier xcd_barrier_post(unsigned* bar, volatile LAS unsigned* st) {
    XcdBarrier b; b.bar = bar; b.x = xb_xcc_id(); b.st = st;
    if (threadIdx.x == 0) (void)xb_add(&bar[XB_XCNT(b.x)], 1u);
    return b;
}
__device__ __forceinline__ void xcd_barrier_complete(unsigned* bar, unsigned x, unsigned& nloc, unsigned& nx) {
    const unsigned G = gridDim.x * gridDim.y * gridDim.z;
    unsigned sum, cnt, mine, sp = 0u;
    for (;;) {
        sum = 0u; cnt = 0u; mine = 0u;
#pragma unroll
        for (unsigned j = 0; j < 16; ++j) { const unsigned c = xb_ld(&bar[XB_XCNT(j)]); sum += c; cnt += (c > 0u) ? 1u : 0u; mine = (j == x) ? c : mine; }
        if (sum == G) break;
        __builtin_amdgcn_s_sleep(1);
        if ((++sp & 255u) == 0u) { if (xb_ld(&bar[XB_TMO])) break; if (sp > XB_SPIN_CAP) { atomicAdd(&bar[XB_TMO], 1u); break; } }
    }
    nloc = mine > 0u ? mine : 1u; nx = cnt > 0u ? cnt : 1u;
}
__device__ __forceinline__ void xcd_barrier(const XcdBarrier& b, bool t0) {
    asm volatile("s_waitcnt vmcnt(0)" ::: "memory");
    __syncthreads();
    if (t0) {
        unsigned* bar = b.bar;
        __builtin_amdgcn_s_waitcnt(0);
        unsigned nloc = b.st[0], nx = b.st[1];
        if (nloc == 0u) { xcd_barrier_complete(bar, b.x, nloc, nx); b.st[0] = nloc; b.st[1] = nx; }
#if MK_EARLYWB
        __builtin_amdgcn_fence(__ATOMIC_RELEASE, "agent"); asm volatile("s_waitcnt vmcnt(0)" ::: "memory");
#endif
        const unsigned old = xb_add(&bar[XB_XSUB(b.x)], 1u);
        const unsigned gen = old / nloc;
        if (old + 1u == (gen + 1u) * nloc) {
            __builtin_amdgcn_fence(__ATOMIC_RELEASE, "agent");
            asm volatile("s_waitcnt vmcnt(0)" ::: "memory");
            const unsigned og = xb_add(&bar[XB_TOP], 1u);
            const unsigned tg = og / nx;
            if (og + 1u == (tg + 1u) * nx) xb_add(&bar[XB_TOPGEN], 1u);
            else XB_SPIN(xb_ld(&bar[XB_TOPGEN]) == tg, bar);
            __builtin_amdgcn_fence(__ATOMIC_ACQUIRE, "agent");
            xb_add(&bar[XB_XGEN(b.x)], 1u);
            asm volatile("s_waitcnt vmcnt(0)" ::: "memory");
        } else {
            XB_SPIN(xb_ld(&bar[XB_XGEN(b.x)]) == gen, bar);
            __builtin_amdgcn_fence(__ATOMIC_ACQUIRE, "agent");
            asm volatile("s_waitcnt vmcnt(0)" ::: "memory");
        }
    }
    __syncthreads();
}

constexpr int RING_OFF = 0, RING_BYTES = 131072;
constexpr int XBUF_OFF = RING_BYTES;
constexpr int RTAB_OFF = RING_BYTES + 8192;
constexpr int LDSCTL_OFF = 155648, MISC_OFF = LDSCTL_OFF + 320;
constexpr int LDS_BYTES = 163840;
static_assert(MISC_OFF + 128 <= LDS_BYTES, "LDS map");

struct Args { const float* in[N_IN]; float* out; unsigned char* ws; int ph_lo, ph_hi; };
static_assert(sizeof(Args) == N_IN * 8 + 24, "Args has no padding");

struct Frame {
    LAS unsigned char* lds;
    int tid, lane, wave, vcu, G;
    const float* const* in;
    float* out; unsigned char* ws;
};
__device__ __forceinline__ const float* gin(const Frame& F, int i) { return (const float*)(const GAS float*)F.in[i]; }
__device__ __forceinline__ bf16* wlayer(const Frame& F, int l, size_t off) { return (bf16*)(F.ws + WS_W + (size_t)l * WL_STRIDE + off); }
__device__ __forceinline__ const float* modp(const Frame& F, int l, int bi) { return (const float*)(F.ws + WS_MOD) + ((size_t)l * 5 + bi) * 6144; }
__device__ __forceinline__ int row_bidx(int r) { return r < NCTXROWS ? 0 : 1 + ((r - NCTXROWS) >> 11); }

__device__ __forceinline__ float row_rstd(const float* RSS, size_t row) {
    const f32x4 a = *(const f32x4*)(RSS + row * 4);
    return __builtin_amdgcn_rsqf(((a.x + a.y) + (a.z + a.w)) * (1.f / D) + 1e-6f);
}
namespace pg8 {
struct EpiProj {
    static constexpr bool PERM = true, AFTER_DRAIN = false;
    bf16_t* O; bf16_t* AUX; const float* RSS; const float* bias0; const PG8_LAS float* rtab; int rpm;
    __device__ __forceinline__ void operator()(const f32x4 (&acc)[2][2][4][2], const Unit& u, int wr, int wc, int fr, int fq) const {
        const int row0 = u.pm * BM + wr * 64 + fr; const int ct0 = wc * 32 + 8 * fq; const int col0 = u.pn * BM + ct0;
        const int bi = u.pm < 32 ? 0 : 1 + ((u.pm - 32) >> 3); const float* bp = bias0 + (size_t)bi * PIN + col0;
#pragma unroll
        for (int bj = 0; bj < 2; ++bj) { f32x4 b0 = *(const f32x4*)(bp + bj * HALF), b1 = *(const f32x4*)(bp + bj * HALF + 4);

#pragma unroll
          for (int ai = 0; ai < 2; ++ai)
#pragma unroll
            for (int m = 0; m < 4; ++m) { const size_t row = (size_t)(row0 + ai * HALF + m * 16); const float rs = u.pm == rpm ? rtab[wr * 64 + fr + ai * HALF + m * 16] : row_rstd(RSS, row);
                const f32x4 v0 = acc[ai][bj][m][0] * rs + b0, v1 = acc[ai][bj][m][1] * rs + b1;
                u32x4 w; w.x = cvt_pk_bf16(v0[0], v0[1]); w.y = cvt_pk_bf16(v0[2], v0[3]); w.z = cvt_pk_bf16(v1[0], v1[1]); w.w = cvt_pk_bf16(v1[2], v1[3]);
                if (MK_WTSEL & 1) st16_wt(O + row * PIN + col0 + bj * HALF, w); else *(u32x4*)(O + row * PIN + col0 + bj * HALF) = w;
                if (u.pn == 6) { float t[8] = {v0[0], v0[1], v0[2], v0[3], v1[0], v1[1], v1[2], v1[3]};
                    if (bj == 1) {
#pragma unroll
                        for (int e = 0; e < 8; ++e) t[e] = fsigmoid(t[e]); }
                    else if (wc < 2) {
#pragma unroll
                        for (int e = 0; e < 8; ++e) t[e] = ftanh(t[e]); }
                    u32x4 a; a.x = cvt_pk_bf16(t[0], t[1]); a.y = cvt_pk_bf16(t[2], t[3]); a.z = cvt_pk_bf16(t[4], t[5]); a.w = cvt_pk_bf16(t[6], t[7]);
                    if (MK_WTSEL & 2) st16_wt(AUX + row * NAUX + ct0 + bj * HALF, a); else *(u32x4*)(AUX + row * NAUX + ct0 + bj * HALF) = a; } } }
    }
};
struct EpiDec {
    static constexpr bool PERM = true, AFTER_DRAIN = false;
    bf16_t* O; const float* w0; const float* a0;
    __device__ __forceinline__ void operator()(const f32x4 (&acc)[2][2][4][2], const Unit& u, int wr, int wc, int fr, int fq) const {
        const int row0 = u.pm * BM + wr * 64 + fr; const int ct0 = wc * 32 + 8 * fq; const int col0 = u.pn * BM + ct0;
        const int kind = u.pn < 4 ? 0 : (u.pn < 8 ? 1 : 2);
        const float* bp = kind == 0 ? w0 + u.pn * 256 : a0 + (u.pn - 4) * 256;
        const float s = kind == 0 ? -DECAY_SCALE : 1.0f;
#pragma unroll
        for (int bj = 0; bj < 2; ++bj) {
            v2u ob[2][4];
#pragma unroll
          for (int n = 0; n < 2; ++n) {
            const f32x4 b0 = kind < 2 ? *(const f32x4*)(bp + ct0 + bj * HALF + 4 * n) : (f32x4){0.f, 0.f, 0.f, 0.f};
#pragma unroll
            for (int ai = 0; ai < 2; ++ai)
#pragma unroll
                for (int m = 0; m < 4; ++m) { bf16_t* rowp = O + (size_t)(row0 + ai * HALF + m * 16) * NDEC + col0 + bj * HALF;
                    f32x4 v0 = acc[ai][bj][m][n] + b0;
                    if (kind < 2) {
#pragma unroll
                        for (int e = 0; e < 4; ++e) v0[e] = s * fsigmoid(v0[e]); }
                    v2u w; w.x = cvt_pk_bf16(v0[0], v0[1]); w.y = cvt_pk_bf16(v0[2], v0[3]);
                    if (n == 0) ob[ai][m] = w; else { u32x4 ww; ww.x = ob[ai][m].x; ww.y = ob[ai][m].y; ww.z = w.x; ww.w = w.y; *(u32x4*)rowp = ww; } }
          } }
    }
};
struct EpiLru {
    static constexpr bool PERM = true, AFTER_DRAIN = false;
    bf16_t* LRU; const bf16_t* XC; const float* gab; const float* gxb; const float* spt;
    template <bool SER> __device__ __forceinline__ void body(const f32x4 (&acc)[2][2][4][2], int d, int row0, int c0, const f32x4 (&nbga)[2], const f32x4 (&nbgx)[2], const f32x4 (&sp)[2]) const {
#pragma unroll
        for (int ai = 0; ai < 2; ++ai)
#pragma unroll
            for (int m = 0; m < 4; ++m) { const size_t row = (size_t)(row0 + ai * HALF + m * 16);
                const u32x4 xw = *(const u32x4*)(XC + row * 512 + c0); const float xc[8] = {bflo(xw.x), bfhi(xw.x), bflo(xw.y), bfhi(xw.y), bflo(xw.z), bfhi(xw.z), bflo(xw.w), bfhi(xw.w)};
                float la[8], uu[8];
#pragma unroll
                for (int n = 0; n < 2; ++n)
#pragma unroll
                    for (int e = 0; e < 4; ++e) {
                        const float rg = __builtin_amdgcn_rcpf(1.0f + __builtin_amdgcn_exp2f(__builtin_fmaf(acc[ai][0][m][n][e], -1.4426950409f, nbga[n][e])));
                        const float ig = __builtin_amdgcn_rcpf(1.0f + __builtin_amdgcn_exp2f(__builtin_fmaf(acc[ai][1][m][n][e], -1.4426950409f, nbgx[n][e])));
                        const float l_ = sp[n][e] * rg, x2 = 2.0f * l_;
                        float em1;
                        if (SER) em1 = -x2 * (1.0f + x2 * (0.5f + x2 * (0.16666667f + x2 * 0.041666668f)));
                        else em1 = x2 > -0.03125f ? -x2 * (1.0f + x2 * (0.5f + x2 * 0.16666667f)) : 1.0f - fexp(x2);
                        la[4 * n + e] = l_; uu[4 * n + e] = __builtin_amdgcn_sqrtf(em1) * (ig * xc[4 * n + e]); }
                bf16_t* p = LRU + (row * 2 + d) * 1024 + c0;
                u32x4 w1; w1.x = cvt_pk_bf16(la[0], la[1]); w1.y = cvt_pk_bf16(la[2], la[3]); w1.z = cvt_pk_bf16(la[4], la[5]); w1.w = cvt_pk_bf16(la[6], la[7]); *(u32x4*)p = w1;
                u32x4 w2; w2.x = cvt_pk_bf16(uu[0], uu[1]); w2.y = cvt_pk_bf16(uu[2], uu[3]); w2.z = cvt_pk_bf16(uu[4], uu[5]); w2.w = cvt_pk_bf16(uu[6], uu[7]); *(u32x4*)(p + 512) = w2; }
    }
    __device__ __forceinline__ void operator()(const f32x4 (&acc)[2][2][4][2], const Unit& u, int wr, int wc, int fr, int fq) const {
        const int row0 = u.pm * BM + wr * 64 + fr; const int d = wc >> 1, c0 = u.pn * 64 + (wc & 1) * 32 + fq * 8;
        asm volatile("" ::: "memory");
        f32x4 nbga[2], nbgx[2], sp[2]; bool big = false;
#pragma unroll
        for (int n = 0; n < 2; ++n) { nbga[n] = *(const f32x4*)(gab + d * 512 + c0 + 4 * n) * -1.4426950409f; nbgx[n] = *(const f32x4*)(gxb + d * 512 + c0 + 4 * n) * -1.4426950409f; sp[n] = *(const f32x4*)(spt + d * 512 + c0 + 4 * n);
#pragma unroll
            for (int e = 0; e < 4; ++e) big |= !(sp[n][e] >= -0.125f && sp[n][e] <= 0.125f); }
        if (__builtin_amdgcn_ballot_w64(big) == 0ull) body<true>(acc, d, row0, c0, nbga, nbgx, sp); else body<false>(acc, d, row0, c0, nbga, nbgx, sp);
    }
};
struct EpiRes {
    static constexpr bool PERM = true, AFTER_DRAIN = false;
    const float* baseA; const float* baseB; const bf16_t* baseH; float* out; bf16_t* outH; const float* gate0; bf16_t* AN; const float* lng; const float* sc0; float* RSS; PG8_LAS float* xb; const float* blng; const float* bsc0;
    __device__ __forceinline__ void operator()(const f32x4 (&acc)[2][2][4][2], const Unit& u, int wr, int wc, int fr, int fq) const {
        const int row0 = u.pm * BM + wr * 64 + fr, col0 = u.pn * BM + wc * 32 + 8 * fq;
        const int bi = u.pm < 32 ? 0 : 1 + ((u.pm - 32) >> 3);
        const float* gp = gate0 + (size_t)bi * 6144 + col0; const float* sp = sc0 ? sc0 + (size_t)bi * 6144 + col0 : nullptr;
        const float* bs = u.pm < 32 ? baseA : baseB - (size_t)NCTXROWS * D;
        if ((MK_TSEL >> 26) & 1) { if (wr == 0 && wc == 0 && fr == 0 && fq == 0) ((volatile PG8_LAS unsigned*)xb)[(MISC_OFF - XBUF_OFF) / 4 + 23] = (unsigned)__builtin_amdgcn_s_memrealtime(); }
        float ss[2][4];
#pragma unroll
        for (int ai = 0; ai < 2; ++ai)
#pragma unroll
            for (int m = 0; m < 4; ++m) ss[ai][m] = 0.f;
#pragma unroll
        for (int bj = 0; bj < 2; ++bj) { const int co = bj * HALF;
            asm volatile("" ::: "memory");
            const f32x4 gv0 = *(const f32x4*)(gp + co), gv1 = *(const f32x4*)(gp + co + 4);
            f32x4 gm0 = *(const f32x4*)(lng + col0 + co), gm1 = *(const f32x4*)(lng + col0 + co + 4);
            if (sp) { gm0 *= *(const f32x4*)(sp + co) + 1.0f; gm1 *= *(const f32x4*)(sp + co + 4) + 1.0f; }
            f32x4 rb0 = {1.f, 1.f, 1.f, 1.f}, rb1 = rb0;
            if (blng) { const float* bq = bsc0 + (size_t)bi * 6144 + col0 + co; const f32x4 q0 = *(const f32x4*)(blng + col0 + co) * (*(const f32x4*)bq + 1.0f), q1 = *(const f32x4*)(blng + col0 + co + 4) * (*(const f32x4*)(bq + 4) + 1.0f);
#pragma unroll
                for (int e = 0; e < 4; ++e) { rb0[e] = q0[e] != 0.f ? __builtin_amdgcn_rcpf(q0[e]) : 0.f; rb1[e] = q1[e] != 0.f ? __builtin_amdgcn_rcpf(q1[e]) : 0.f; } }
#pragma unroll
            for (int ai = 0; ai < 2; ++ai)
#pragma unroll
                for (int m = 0; m < 4; ++m) { const size_t off = (size_t)(row0 + ai * HALF + m * 16) * D + col0 + co;
                    f32x4 b0, b1;
                    if (baseH) { const u32x4 bw = *(const u32x4*)(baseH + off); b0 = (f32x4){bflo(bw.x), bfhi(bw.x), bflo(bw.y), bfhi(bw.y)} * rb0; b1 = (f32x4){bflo(bw.z), bfhi(bw.z), bflo(bw.w), bfhi(bw.w)} * rb1; }
                    else { b0 = *(const f32x4*)(bs + off); b1 = *(const f32x4*)(bs + off + 4); }
                    const f32x4 x0 = b0 + gv0 * acc[ai][bj][m][0], x1 = b1 + gv1 * acc[ai][bj][m][1];
                    if (outH) { u32x4 xw; xw.x = cvt_pk_bf16(x0.x, x0.y); xw.y = cvt_pk_bf16(x0.z, x0.w); xw.z = cvt_pk_bf16(x1.x, x1.y); xw.w = cvt_pk_bf16(x1.z, x1.w); *(u32x4*)(outH + off) = xw; }
                    else if (out) { *(f32x4*)(out + off) = x0; *(f32x4*)(out + off + 4) = x1; }
                    ss[ai][m] += ((x0.x * x0.x + x0.y * x0.y) + (x0.z * x0.z + x0.w * x0.w)) + ((x1.x * x1.x + x1.y * x1.y) + (x1.z * x1.z + x1.w * x1.w));
                    const f32x4 y0 = x0 * gm0, y1 = x1 * gm1; u32x4 w; w.x = cvt_pk_bf16(y0.x, y0.y); w.y = cvt_pk_bf16(y0.z, y0.w); w.z = cvt_pk_bf16(y1.x, y1.y); w.w = cvt_pk_bf16(y1.z, y1.w);
                    if (MK_WTSEL & 4) st16_wt(AN + off, w); else *(u32x4*)(AN + off) = w; }
        }
#pragma unroll
        for (int ai = 0; ai < 2; ++ai)
#pragma unroll
            for (int m = 0; m < 4; ++m) { float s = ss[ai][m]; s += __shfl_xor(s, 16); s += __shfl_xor(s, 32);
                if (fq == 0) xb[(wr * 64 + fr + ai * HALF + m * 16) * 4 + wc] = s; }
        asm volatile("s_waitcnt lgkmcnt(0)" ::: "memory"); __builtin_amdgcn_s_barrier(); asm volatile("" ::: "memory");
        const int tid = (wr * 4 + wc) * 64 + fq * 16 + fr;
        if (tid < 256) { const f32x4 p = *(const PG8_LAS f32x4*)(xb + tid * 4); RSS[(size_t)(u.pm * BM + tid) * 4 + u.pn] = (p.x + p.y) + (p.z + p.w); }
        if ((MK_TSEL >> 26) & 1) { asm volatile("s_waitcnt vmcnt(0)" ::: "memory"); if (tid == 0) { volatile PG8_LAS unsigned* mm = (volatile PG8_LAS unsigned*)xb + (MISC_OFF - XBUF_OFF) / 4; mm[22] += (unsigned)__builtin_amdgcn_s_memrealtime() - mm[23]; } }
    }
};
template <int CTRL, bool BC> __device__ __forceinline__ float dpp_f(float oldv, float x) {
    return __builtin_bit_cast(float, __builtin_amdgcn_update_dpp(__builtin_bit_cast(int, oldv), __builtin_bit_cast(int, x), CTRL, 0xf, 0xf, BC));
}
struct EpiFfn {
    static constexpr bool PERM = true, AFTER_DRAIN = false;
    bf16_t* ACT; const float* cw; const float* cb; PG8_LAS float* xbuf; const float* RSS; const float* bias0; const PG8_LAS float* rtab; int rpm; volatile PG8_LAS unsigned* tacc;
    __device__ __forceinline__ void operator()(f32x4 (&acc)[2][2][4][2], const Unit& u, int wr, int wc, int fr_in, int fq_in) const {
        int ln_; asm volatile("v_mbcnt_lo_u32_b32 %0, -1, 0\n\tv_mbcnt_hi_u32_b32 %0, -1, %0" : "=v"(ln_)); const int fr = ln_ & 15, fq = ln_ >> 4;
        (void)fr_in; (void)fq_in;
        const unsigned long long te0_ = (MK_TSEL >> 17) & 1 ? __builtin_amdgcn_s_memrealtime() : 0ull;
        const bool ctx = u.pm < 32;
        const int wid = wr * 4 + wc;
        {
            const int bi = u.pm < 32 ? 0 : 1 + ((u.pm - 32) >> 3); const float* bp = bias0 + (size_t)bi * 5632 + u.pn * 128 + wc * 32 + 8 * fq;
            f32x4 bv[2][2];
#pragma unroll
            for (int bj = 0; bj < 2; ++bj)
#pragma unroll
                for (int n = 0; n < 2; ++n) { f32x4 b_ = *(const f32x4*)(bp + bj * 2816 + 4 * n);
                    bv[bj][n] = b_; }
#pragma unroll
            for (int ai = 0; ai < 2; ++ai)
#pragma unroll
                for (int m = 0; m < 4; ++m) { const float rs = u.pm == rpm ? rtab[wr * 64 + fr + ai * HALF + m * 16] : row_rstd(RSS, (size_t)(u.pm * BM + wr * 64 + fr + ai * HALF + m * 16));
#pragma unroll
                    for (int bj = 0; bj < 2; ++bj)
#pragma unroll
                        for (int n = 0; n < 2; ++n) acc[ai][bj][m][n] = acc[ai][bj][m][n] * rs + bv[bj][n]; }
        }
        if (ctx) {
#pragma unroll
            for (int ai = 0; ai < 2; ++ai)
#pragma unroll
                for (int bj = 0; bj < 2; ++bj)
#pragma unroll
                    for (int n = 0; n < 2; ++n) {
                        if (fr == 0)  *(PG8_LAS f32x4*)(xbuf + ((((wid * 2 + ai) * 2 + 0) * 4 + fq) * 4 + bj * 2 + n) * 4) = acc[ai][bj][0][n];
                        if (fr == 15) *(PG8_LAS f32x4*)(xbuf + ((((wid * 2 + ai) * 2 + 1) * 4 + fq) * 4 + bj * 2 + n) * 4) = acc[ai][bj][3][n];
                    }
            asm volatile("s_waitcnt lgkmcnt(0)" ::: "memory"); __builtin_amdgcn_s_barrier(); asm volatile("" ::: "memory");
        }
        const int row0 = u.pm * BM + wr * 64 + fr; const int ct0 = wc * 32 + 8 * fq;
#pragma unroll
        for (int n = 0; n < 2; ++n) {
            const int ca = u.pn * 128 + ct0 + 4 * n;
            asm volatile("" ::: "memory");
            const f32x4 w0a = *(const f32x4*)(cw + ca), w1a = *(const f32x4*)(cw + 5632 + ca), w2a = *(const f32x4*)(cw + 2 * 5632 + ca), cba = *(const f32x4*)(cb + ca);
            const f32x4 w0b = *(const f32x4*)(cw + 2816 + ca), w1b = *(const f32x4*)(cw + 5632 + 2816 + ca), w2b = *(const f32x4*)(cw + 2 * 5632 + 2816 + ca), cbb = *(const f32x4*)(cb + 2816 + ca);
#pragma unroll
            for (int ai = 0; ai < 2; ++ai) {
                const int blk = 2 * ai + wr;
                f32x4 pa = {0.f, 0.f, 0.f, 0.f}, pb = pa, na = pa, nb = pa;
                if (ctx && blk > 0) { const int pw = ((blk - 1) & 1) * 4 + wc, pai = (blk - 1) >> 1;
                    pa = *(const PG8_LAS f32x4*)(xbuf + ((((pw * 2 + pai) * 2 + 1) * 4 + fq) * 4 + 0 * 2 + n) * 4); pb = *(const PG8_LAS f32x4*)(xbuf + ((((pw * 2 + pai) * 2 + 1) * 4 + fq) * 4 + 1 * 2 + n) * 4); }
                if (ctx && blk < 3) { const int nw = ((blk + 1) & 1) * 4 + wc, nai = (blk + 1) >> 1;
                    na = *(const PG8_LAS f32x4*)(xbuf + ((((nw * 2 + nai) * 2 + 0) * 4 + fq) * 4 + 0 * 2 + n) * 4); nb = *(const PG8_LAS f32x4*)(xbuf + ((((nw * 2 + nai) * 2 + 0) * 4 + fq) * 4 + 1 * 2 + n) * 4); }
#pragma unroll
                for (int m = 0; m < 4; ++m) {
                    float o[4];
#pragma unroll
                    for (int e = 0; e < 4; ++e) {
                        const float xa = acc[ai][0][m][n][e], xb = acc[ai][1][m][n][e];
                        const float ta = m > 0 ? dpp_f<0x10F, true>(0.f, acc[ai][0][m > 0 ? m - 1 : 0][n][e]) : pa[e];
                        const float tb = m > 0 ? dpp_f<0x10F, true>(0.f, acc[ai][1][m > 0 ? m - 1 : 0][n][e]) : pb[e];
                        const float ba = m < 3 ? dpp_f<0x11F, true>(0.f, acc[ai][0][m < 3 ? m + 1 : 3][n][e]) : na[e];
                        const float bb = m < 3 ? dpp_f<0x11F, true>(0.f, acc[ai][1][m < 3 ? m + 1 : 3][n][e]) : nb[e];
                        const float upa = dpp_f<0x111, false>(ta, xa), upb = dpp_f<0x111, false>(tb, xb);
                        const float dna = dpp_f<0x101, false>(ba, xa), dnb = dpp_f<0x101, false>(bb, xb);
                        const float ua = cba[e] + w0a[e] * upa + w1a[e] * xa + w2a[e] * dna;
                        const float ub = cbb[e] + w0b[e] * upb + w1b[e] * xb + w2b[e] * dnb;
                        o[e] = gelu_tanh(ua) * ub; }
                    v2u w; w.x = cvt_pk_bf16(o[0], o[1]); w.y = cvt_pk_bf16(o[2], o[3]);
                    *(v2u*)(ACT + (size_t)(row0 + ai * HALF + m * 16) * DFF + ca) = w;
                }
            }
        }
        if ((MK_TSEL >> 17) & 1) { asm volatile("s_waitcnt vmcnt(0)" ::: "memory"); if (wr == 0 && wc == 0 && ln_ == 0) tacc[0] += (unsigned)(__builtin_amdgcn_s_memrealtime() - te0_); }
    }
};
}

template <class RowMap>
__device__ __forceinline__ void transpose_item(const float* W, int srcN, int k0, int n0, bf16* dst, int dstK, int kdst0, RowMap rm, LAS float* scr, int lane) {
    float tv[32];
#pragma unroll
    for (int i = 0; i < 32; ++i) tv[i] = W[(size_t)(k0 + 2 * i + (lane >> 5)) * srcN + n0 + (lane & 31)];
#pragma unroll
    for (int i = 0; i < 32; ++i) scr[(2 * i + (lane >> 5)) * 33 + (lane & 31)] = tv[i];
    LDS_WAIT(); asm volatile("" ::: "memory");
    const int c = lane & 7;
#pragma unroll
    for (int j = 0; j < 4; ++j) { const int n = (lane >> 3) + 8 * j; const LAS float* s = scr + (8 * c) * 33 + n;
        v4u o; o.x = pk2(s[0 * 33], s[1 * 33]); o.y = pk2(s[2 * 33], s[3 * 33]); o.z = pk2(s[4 * 33], s[5 * 33]); o.w = pk2(s[6 * 33], s[7 * 33]);
        *(GAS v4u*)(dst + (size_t)rm(n) * dstK + kdst0 + 8 * c) = o; }
    LDS_WAIT(); asm volatile("" ::: "memory");
}
constexpr int IT_IN = 16 * 88, IT_OUT = 16 * 32, IT_UP = 16 * 176, IT_DOWN = 44 * 32, IT_AUX = 96, IT_LRU = 64, IT_LAYER = IT_IN + IT_OUT + IT_UP + IT_DOWN + IT_AUX + IT_LRU;
constexpr int ZR_LAYER = NDEC + NLRU;
constexpr int N_T0 = DEPTH * IT_LAYER, N_T1 = DEPTH * ZR_LAYER, N_T2 = DEPTH * 8 * 24;
constexpr int IT_EARLY = IT_IN + IT_UP + IT_AUX + IT_LRU, IT_LATE = IT_OUT + IT_DOWN;
__device__ __forceinline__ void p0_prologue(Frame& F, const int lay0, const int nlay, const int gw, const int NGW, const bool do_mod, const int part = 0) {
    LAS float* scr = (LAS float*)(F.lds + RING_OFF + F.wave * 16384);
    const int lane = F.lane;
    const unsigned long long tp0_ = (MK_TSEL >> 24) & 3 ? __builtin_amdgcn_s_memrealtime() : 0ull;
    if (do_mod) for (int t = F.wave * F.G + F.vcu; t < N_T2; t += F.G * NWAVES) {
        const int l = t / 192, ks = (t % 192) / 24, nb = t % 24;
        const float* W = gin(F, I_WMOD) + ((size_t)l * 1024 + ks * 128) * 6144 + nb * 256 + lane * 4;
#pragma unroll
        for (int i = 0; i < 10; ++i) { const int idx = lane + 64 * i, b = idx >> 7, k = idx & 127; const float cv = b == 0 ? gin(F, I_CCTX)[ks * 128 + k] : gin(F, I_C)[(b - 1) * 1024 + ks * 128 + k]; scr[idx] = cv * fsigmoid(cv); }
        LDS_WAIT(); asm volatile("" ::: "memory");
        f32x4 a0 = {0.f, 0.f, 0.f, 0.f}, a1 = a0, a2 = a0, a3 = a0, a4 = a0;
        f32x4 w[2][16];
#pragma unroll
        for (int i = 0; i < 16; ++i) w[0][i] = *(const GAS f32x4*)(W + (size_t)i * 6144);
#pragma unroll
        for (int kb = 0; kb < 8; ++kb) { const int k0 = 16 * kb;
            if (kb < 7) {
#pragma unroll
                for (int i = 0; i < 16; ++i) w[(kb + 1) & 1][i] = *(const GAS f32x4*)(W + (size_t)(k0 + 16 + i) * 6144); }
#pragma unroll
            for (int i = 0; i < 16; i += 4) { const f32x4 s0 = *(const LAS f32x4*)(scr + k0 + i), s1 = *(const LAS f32x4*)(scr + 128 + k0 + i), s2 = *(const LAS f32x4*)(scr + 256 + k0 + i), s3 = *(const LAS f32x4*)(scr + 384 + k0 + i), s4 = *(const LAS f32x4*)(scr + 512 + k0 + i);
#pragma unroll
                for (int e = 0; e < 4; ++e) { const f32x4 ww = w[kb & 1][i + e]; a0 += s0[e] * ww; a1 += s1[e] * ww; a2 += s2[e] * ww; a3 += s3[e] * ww; a4 += s4[e] * ww; } } }
        float* P = (float*)(F.ws + WS_MODP) + (((size_t)l * 8 + ks) * 5) * 6144 + nb * 256 + lane * 4;
        *(f32x4*)(P) = a0; *(f32x4*)(P + 6144) = a1; *(f32x4*)(P + 2 * 6144) = a2; *(f32x4*)(P + 3 * 6144) = a3; *(f32x4*)(P + 4 * 6144) = a4;
        LDS_WAIT(); asm volatile("" ::: "memory");
    }
    const unsigned long long tp1_ = (MK_TSEL >> 24) & 3 ? __builtin_amdgcn_s_memrealtime() : 0ull;
    {
        struct TDesc { const float* src; bf16* dst; int srcN, dstK, rb, lru; };
        auto decode = [&](int it, TDesc& d) {
            const int l = lay0 + (part ? 0 : it / IT_LAYER); const int q_ = part == 0 ? it % IT_LAYER : (part == 1 ? it : IT_EARLY + it); d.lru = 0;
            int r = q_ < IT_IN ? q_ : q_ < IT_IN + IT_UP ? q_ + IT_OUT : q_ < IT_EARLY ? q_ + IT_OUT + IT_DOWN : q_ < IT_EARLY + IT_OUT ? q_ - IT_EARLY + IT_IN : q_ - IT_EARLY - IT_OUT + IT_IN + IT_OUT + IT_UP;
            if (r < IT_IN) { const int kb = r / 88, nb = r % 88; d.src = gin(F, I_WIN) + (size_t)l * 1024 * PIN + (size_t)(64 * kb) * PIN + 32 * nb; d.srcN = PIN; d.dst = wlayer(F, l, WL_IN) + 64 * kb; d.dstK = 1024; d.rb = 32 * nb; return; } r -= IT_IN;
            if (r < IT_OUT) { const int kb = r / 32, nb = r % 32; d.src = gin(F, I_WOUT) + (size_t)l * 1024 * 1024 + (size_t)(64 * kb) * 1024 + 32 * nb; d.srcN = 1024; d.dst = wlayer(F, l, WL_OUT) + 64 * kb; d.dstK = 1024; d.rb = 32 * nb; return; } r -= IT_OUT;
            if (r < IT_UP) { const int kb = r / 176, nb = r % 176; const int n0 = 32 * nb; const int nn = n0 < DFF ? n0 : n0 - DFF;
                d.src = gin(F, I_WUP) + (size_t)l * 1024 * 5632 + (size_t)(64 * kb) * 5632 + n0; d.srcN = 5632; d.dst = wlayer(F, l, WL_UP) + 64 * kb; d.dstK = 1024; d.rb = 256 * (nn / 128) + (n0 < DFF ? 0 : 128) + (nn % 128); return; } r -= IT_UP;
            if (r < IT_DOWN) { const int kb = r / 32, nb = r % 32; d.src = gin(F, I_WDOWN) + (size_t)l * DFF * 1024 + (size_t)(64 * kb) * 1024 + 32 * nb; d.srcN = 1024; d.dst = wlayer(F, l, WL_DOWN) + 64 * kb; d.dstK = DFF; d.rb = 32 * nb; return; } r -= IT_DOWN;
            if (r < IT_AUX) { d.srcN = 512; d.dstK = 128;
                if (r < 32) { const int dd = r / 16, nb = r % 16; d.src = gin(F, I_RW_WUP) + ((size_t)l * 2 + dd) * 64 * 512 + 32 * nb; d.dst = wlayer(F, l, WL_AUX); d.rb = dd * 512 + 32 * nb; }
                else if (r < 64) { const int dd = (r - 32) / 16, nb = r % 16; d.src = gin(F, I_RW_AUP) + ((size_t)l * 2 + dd) * 64 * 512 + 32 * nb; d.dst = wlayer(F, l, WL_AUX) + 64; d.rb = 1024 + dd * 512 + 32 * nb; }
                else { const int kb = (r - 64) / 16, nb = r % 16; d.src = gin(F, I_RW_GUP) + (size_t)l * 128 * 512 + (size_t)(64 * kb) * 512 + 32 * nb; d.dst = wlayer(F, l, WL_AUX) + 64 * kb; d.rb = 2048 + 32 * nb; }
                return; } r -= IT_AUX;
            { const int q = r / 16, h = (r % 16) / 2, nb = r % 2;
              d.src = (q < 2 ? gin(F, I_LRU_GAW) : gin(F, I_LRU_GXW)) + (((size_t)l * 2 + (q & 1)) * 8 + h) * 4096 + 32 * nb; d.srcN = 64; d.dst = wlayer(F, l, WL_LRU) + 64 * (h & 1); d.dstK = 128;
              d.rb = 256 * h + 128 * (q >> 1) + 64 * (q & 1) + 32 * nb; }
        };
        TDesc dc, dn; float tc[32], tn[32];
        const int NIT = part == 0 ? nlay * IT_LAYER : (part == 1 ? IT_EARLY : IT_LATE); int it = gw;
        if (it < NIT) { decode(it, dc);
#pragma unroll
            for (int i = 0; i < 32; ++i) tc[i] = dc.src[(size_t)(2 * i + (lane >> 5)) * dc.srcN + (lane & 31)]; }
        for (; it < NIT; it += NGW) {
            const bool hn = it + NGW < NIT;
            if (hn) { decode(it + NGW, dn);
#pragma unroll
                for (int i = 0; i < 32; ++i) tn[i] = dn.src[(size_t)(2 * i + (lane >> 5)) * dn.srcN + (lane & 31)]; }
#pragma unroll
            for (int i = 0; i < 32; ++i) scr[(2 * i + (lane >> 5)) * 33 + (lane & 31)] = tc[i];
            LDS_WAIT(); asm volatile("" ::: "memory");
            { const int c = lane & 7;
#pragma unroll
              for (int j = 0; j < 4; ++j) { const int n = (lane >> 3) + 8 * j; const LAS float* s = scr + (8 * c) * 33 + n;
                  v4u o; o.x = pk2(s[0 * 33], s[1 * 33]); o.y = pk2(s[2 * 33], s[3 * 33]); o.z = pk2(s[4 * 33], s[5 * 33]); o.w = pk2(s[6 * 33], s[7 * 33]);
                  const int row = dc.rb + (dc.lru ? 32 * (n >> 4) + (n & 15) : n);
                  *(GAS v4u*)(dc.dst + (size_t)row * dc.dstK + 8 * c) = o; } }
            LDS_WAIT(); asm volatile("" ::: "memory");
            dc = dn;
#pragma unroll
            for (int i = 0; i < 32; ++i) tc[i] = tn[i];
        }
    }
    if ((MK_TSEL >> 24) & 3) { asm volatile("s_waitcnt vmcnt(0)" ::: "memory"); const unsigned long long tp2_ = __builtin_amdgcn_s_memrealtime(); if (F.wave == 0 && lane == 0 && do_mod) { volatile LAS unsigned* mm = (volatile LAS unsigned*)(F.lds + MISC_OFF); mm[19] += (unsigned)(tp1_ - tp0_); mm[21] += (unsigned)(tp2_ - tp1_); } }
    if (part != 2) for (int t = gw; t < nlay * ZR_LAYER; t += NGW) {
        const int l = lay0 + t / ZR_LAYER, r = t % ZR_LAYER; const int k = 4 * lane;
        v2u zz; zz.x = 0u; zz.y = 0u; asm volatile("" : "+v"(zz.x), "+v"(zz.y));
        if (r < NDEC) { const int lo = r < 1024 ? 0 : (r < 2048 ? 64 : 0), hi = r < 1024 ? 64 : 128;
            if (k < 128 && (k < lo || k >= hi)) *(GAS v2u*)(wlayer(F, l, WL_AUX) + (size_t)r * 128 + k) = zz; }
        else { const int rr = r - NDEC, h = rr >> 8; const int lo = 64 * (h & 1);
            if (k < 128 && (k < lo || k >= lo + 64)) *(GAS v2u*)(wlayer(F, l, WL_LRU) + (size_t)rr * 128 + k) = zz; }
    }
}
__device__ __forceinline__ void p1_modreduce(Frame& F) {
    const int gt = (F.vcu * NWAVES + F.wave) * 64 + F.lane, NT = F.G * NWAVES * 64;
    for (int i = gt; i < DEPTH * 5 * 6144; i += NT) { const int l = i / (5 * 6144), r = i % (5 * 6144), n = r % 6144, bi = r / 6144;
        float s = gin(F, I_BMOD)[l * 6144 + n];
#pragma unroll
        for (int ks = 0; ks < 8; ++ks) s += ((const float*)(F.ws + WS_MODP))[(((size_t)l * 8 + ks) * 5 + bi) * 6144 + n];
        ((float*)(F.ws + WS_MOD))[i] = s; }
    for (int i = gt; i < DEPTH * 1024; i += NT) { const float x = -gin(F, I_LRU_LAM)[i]; ((float*)(F.ws + WS_SPT))[i] = -8.0f * (fmaxf(x, 0.f) + log1pf(expf(-fabsf(x)))); }
}
__device__ __forceinline__ const float* xrow_in(const Frame& F, int r) { return r < NCTXROWS ? gin(F, I_XP) + (size_t)r * D : gin(F, I_XS) + (size_t)(r - NCTXROWS) * D; }
__device__ __forceinline__ void bias_tables(Frame& F, const int lay, const int wgi, const int nwg) {
    const int lane = F.lane;
    {   LAS float* shs = (LAS float*)(F.lds + RING_OFF + F.wave * 8192);
        constexpr int NCB = (PIN + 2 * DFF) / 64;
        const int wq = F.wave & 3, hw = F.wave >> 2;
        for (int t0 = 0; t0 < NCB; t0 += 2 * nwg) { const int tb = t0 + 2 * wgi + hw; const bool act = tb < NCB; const int cb = act ? tb : 0, l = lay; const int kq = wq;
            const bool up = cb >= PIN / 64; const int n = (up ? cb - PIN / 64 : cb) * 64 + lane;
            const float* W = (up ? gin(F, I_WUP) + (size_t)l * 1024 * 5632 : gin(F, I_WIN) + (size_t)l * 1024 * PIN) + (size_t)(256 * kq) * (up ? 5632 : PIN) + n; const int ldw = up ? 5632 : PIN;
#pragma unroll
            for (int b = 0; b < 5; ++b) { const f32x4 h = *(const f32x4*)(modp(F, l, b) + (up ? 3072 : 0) + 256 * kq + 4 * lane); *(LAS f32x4*)(shs + b * 256 + 4 * lane) = h; }
            LDS_WAIT(); asm volatile("" ::: "memory");
            float a0 = 0.f, a1 = 0.f, a2 = 0.f, a3 = 0.f, a4 = 0.f;
            if (act) { float w[2][16];
#pragma unroll
                for (int i = 0; i < 16; ++i) w[0][i] = *(const GAS float*)(W + (size_t)i * ldw);
#pragma unroll 2
                for (int kb = 0; kb < 16; ++kb) { const int k0 = 16 * kb; const int kn = kb < 15 ? k0 + 16 : k0;
#pragma unroll
                    for (int i = 0; i < 16; ++i) w[(kb + 1) & 1][i] = *(const GAS float*)(W + (size_t)(kn + i) * ldw);
#pragma unroll
                    for (int i = 0; i < 16; i += 4) { const f32x4 h0 = *(const LAS f32x4*)(shs + k0 + i), h1 = *(const LAS f32x4*)(shs + 256 + k0 + i), h2 = *(const LAS f32x4*)(shs + 512 + k0 + i), h3 = *(const LAS f32x4*)(shs + 768 + k0 + i), h4 = *(const LAS f32x4*)(shs + 1024 + k0 + i);
#pragma unroll
                        for (int e = 0; e < 4; ++e) { const float ww = w[kb & 1][i + e]; a0 += h0[e] * ww; a1 += h1[e] * ww; a2 += h2[e] * ww; a3 += h3[e] * ww; a4 += h4[e] * ww; } } } }
            shs[1536 + lane] = a0; shs[1600 + lane] = a1; shs[1664 + lane] = a2; shs[1728 + lane] = a3; shs[1792 + lane] = a4;
            LDS_WAIT(); __syncthreads();
            if (wq == 0 && act) { float* dst = (float*)(F.ws + WS_BIAS) + (up ? BIAS_UP_OFF + (size_t)l * 5 * 5632 : (size_t)l * 5 * PIN) + n; const int ldb = up ? 5632 : PIN;
#pragma unroll
                for (int b = 0; b < 5; ++b) { float s = 0.f;
#pragma unroll
                    for (int q = 0; q < 4; ++q) s += ((const LAS float*)(F.lds + RING_OFF + (hw * 4 + q) * 8192))[1536 + 64 * b + lane];
                    dst[(size_t)b * ldb] = s; } }
            __syncthreads(); }
    }
}
__device__ __forceinline__ void p2_prep(Frame& F) {
    const int gw = F.vcu * NWAVES + F.wave, NGW = F.G * NWAVES; const int lane = F.lane;
    float* RSS = (float*)(F.ws + WS_RSS);
    for (int r0 = gw; r0 < M; r0 += 2 * NGW) {
        f32x4 v[2][4];
#pragma unroll
        for (int u = 0; u < 2; ++u) { const int r = r0 + u * NGW; const GAS f32x4* xr = (const GAS f32x4*)xrow_in(F, r < M ? r : r0) + lane;
#pragma unroll
            for (int j = 0; j < 4; ++j) v[u][j] = xr[64 * j]; }
#pragma unroll
        for (int u = 0; u < 2; ++u) { const int r = r0 + u * NGW; if (r >= M) break; const float* mp = modp(F, 0, row_bidx(r));
            GAS unsigned long long* o8 = (GAS unsigned long long*)((bf16*)(F.ws + WS_XN) + (size_t)r * D) + lane; float s = 0.f;
#pragma unroll
            for (int j = 0; j < 4; ++j) { const f32x4 x = v[u][j]; s += (x.x * x.x + x.y * x.y) + (x.z * x.z + x.w * x.w); const int c = 4 * lane + 256 * j;
                const f32x4 y = x * *(const f32x4*)(gin(F, I_LN1G) + c) * (*(const f32x4*)(mp + 1024 + c) + 1.0f);
                o8[64 * j] = (unsigned long long)pk2(y.x, y.y) | ((unsigned long long)pk2(y.z, y.w) << 32); }
            s = wave_sum(s);
            if (lane < 4) RSS[(size_t)r * 4 + lane] = lane == 0 ? s : 0.f; } }
    const unsigned long long tb0_ = (MK_TSEL >> 27) & 1 ? __builtin_amdgcn_s_memrealtime() : 0ull;
    bias_tables(F, 0, F.vcu, F.G);
    if ((MK_TSEL >> 27) & 1) { asm volatile("s_waitcnt vmcnt(0)" ::: "memory"); if (F.tid == 0) ((volatile LAS unsigned*)(F.lds + MISC_OFF))[19] += (unsigned)(__builtin_amdgcn_s_memrealtime() - tb0_); }
}
__device__ __forceinline__ void p_finalnorm(Frame& F) {
    const int gw = F.vcu * NWAVES + F.wave, NGW = F.G * NWAVES; const float* RSS = (const float*)(F.ws + WS_RSS);
    const bf16* XH = (const bf16*)(F.ws + WS_XN);
    for (int r0 = gw; r0 < M; r0 += 2 * NGW) { v4u a[2][2]; float rs[2];
#pragma unroll
        for (int u = 0; u < 2; ++u) { const int r = r0 + u * NGW < M ? r0 + u * NGW : r0; const GAS v4u* xp = (const GAS v4u*)(XH + (size_t)r * D + 16 * F.lane); a[u][0] = xp[0]; a[u][1] = xp[1]; rs[u] = row_rstd(RSS, (size_t)r); }
#pragma unroll
        for (int u = 0; u < 2; ++u) { const int r = r0 + u * NGW; if (r >= M) break; GAS f32x4* op = (GAS f32x4*)(F.out + (size_t)r * D + 16 * F.lane);
#pragma unroll
            for (int h = 0; h < 2; ++h) { const v4u w = a[u][h];
                op[2 * h] = (f32x4){bflo(w.x), bfhi(w.x), bflo(w.y), bfhi(w.y)} * rs[u]; op[2 * h + 1] = (f32x4){bflo(w.z), bfhi(w.z), bflo(w.w), bfhi(w.w)} * rs[u]; } } }
}
__device__ __forceinline__ void ld8(const bf16* p, float (&o)[8]) { const v4u w = *(const GAS v4u*)p; o[0] = bflo(w.x); o[1] = bfhi(w.x); o[2] = bflo(w.y); o[3] = bfhi(w.y); o[4] = bflo(w.z); o[5] = bfhi(w.z); o[6] = bflo(w.w); o[7] = bfhi(w.w); }
__device__ __forceinline__ void ld8f(const float* p, float (&o)[8]) { const f32x4 a = *(const f32x4*)p, b = *(const f32x4*)(p + 4); o[0] = a.x; o[1] = a.y; o[2] = a.z; o[3] = a.w; o[4] = b.x; o[5] = b.y; o[6] = b.z; o[7] = b.w; }
__device__ __forceinline__ float sum8lanes(float v) { v += __shfl_xor(v, 1); v += __shfl_xor(v, 2); v += __shfl_xor(v, 4); return v; }
__device__ __forceinline__ void p_lruconv(Frame& F, int l) {
    const int gt = (F.vcu * NWAVES + F.wave) * 64 + F.lane, NT = F.G * NWAVES * 64;
    const bf16* PROJ = (const bf16*)(F.ws + WS_PROJ); bf16* XC = (bf16*)F.out;
    const float* cw = gin(F, I_LRU_CW) + l * 4 * 512; const float* cb = gin(F, I_LRU_CB) + l * 512;
    {
        const int c = (gt & 63) * 8; float wv[4][8], bv[8];
#pragma unroll
        for (int j = 0; j < 4; ++j) ld8f(cw + j * 512 + c, wv[j]);
        ld8f(cb + c, bv);
        for (int i = gt; i < M * 64; i += NT) { const int r = i >> 6;
            const int p = r < NCTXROWS ? (r & 255) : ((r - NCTXROWS) & 63), L = r < NCTXROWS ? 256 : 64;
            v4u w[4];
#pragma unroll
            for (int j = 0; j < 4; ++j) { const int q = p + j - 2; const bool ok = q >= 0 && q < L; w[j] = ok ? *(const GAS v4u*)(PROJ + (size_t)(r + j - 2) * PIN + C_XB + c) : (v4u){0u, 0u, 0u, 0u}; }
            float a[8];
#pragma unroll
            for (int e = 0; e < 8; ++e) a[e] = bv[e];
#pragma unroll
            for (int j = 0; j < 4; ++j) { a[0] += bflo(w[j].x) * wv[j][0]; a[1] += bfhi(w[j].x) * wv[j][1]; a[2] += bflo(w[j].y) * wv[j][2]; a[3] += bfhi(w[j].y) * wv[j][3];
                a[4] += bflo(w[j].z) * wv[j][4]; a[5] += bfhi(w[j].z) * wv[j][5]; a[6] += bflo(w[j].w) * wv[j][6]; a[7] += bfhi(w[j].w) * wv[j][7]; }
            v4u o; o.x = pk2(a[0], a[1]); o.y = pk2(a[2], a[3]); o.z = pk2(a[4], a[5]); o.w = pk2(a[6], a[7]);
            *(GAS v4u*)(XC + (size_t)r * 512 + c) = o; }
    }
}
__device__ __forceinline__ void p_lruconv_chunks(Frame& F, int l, int clo, int ncnk) {
    const bf16* PROJ = (const bf16*)(F.ws + WS_PROJ); bf16* XC = (bf16*)F.out;
    const float* cw = gin(F, I_LRU_CW) + l * 4 * 512; const float* cb = gin(F, I_LRU_CB) + l * 512;
    const int c = F.lane * 8; float wv[4][8], bv[8];
#pragma unroll
    for (int j = 0; j < 4; ++j) ld8f(cw + j * 512 + c, wv[j]);
    ld8f(cb + c, bv);
    for (int ck = F.wave; ck < ncnk; ck += NWAVES) { const int r0 = (clo + ck) * 8;
        const int p0 = r0 < NCTXROWS ? (r0 & 255) : ((r0 - NCTXROWS) & 63), L = r0 < NCTXROWS ? 256 : 64;
        v4u w[11];
#pragma unroll
        for (int j = 0; j < 11; ++j) { const int q = p0 + j - 2; const bool ok = q >= 0 && q < L; w[j] = ok ? *(const GAS v4u*)(PROJ + (size_t)(r0 + j - 2) * PIN + C_XB + c) : (v4u){0u, 0u, 0u, 0u}; }
#pragma unroll
        for (int i = 0; i < 8; ++i) { float a[8];
#pragma unroll
            for (int e = 0; e < 8; ++e) a[e] = bv[e];
#pragma unroll
            for (int j = 0; j < 4; ++j) { const v4u x = w[i + j]; a[0] += bflo(x.x) * wv[j][0]; a[1] += bfhi(x.x) * wv[j][1]; a[2] += bflo(x.y) * wv[j][2]; a[3] += bfhi(x.y) * wv[j][3];
                a[4] += bflo(x.z) * wv[j][4]; a[5] += bfhi(x.z) * wv[j][5]; a[6] += bflo(x.w) * wv[j][6]; a[7] += bfhi(x.w) * wv[j][7]; }
            v4u o; o.x = pk2(a[0], a[1]); o.y = pk2(a[2], a[3]); o.z = pk2(a[4], a[5]); o.w = pk2(a[6], a[7]);
            *(GAS v4u*)(XC + (size_t)(r0 + i) * 512 + c) = o; }
    }
}
__device__ __forceinline__ void rwkv_scan_naive(Frame& F, int l, int task, LAS float* scr) {
    const bool lat = task < 64; const int tt0 = lat ? task : task - 64; const int s = tt0 >> 4, d = (tt0 >> 3) & 1, h = tt0 & 7;
    const int T = lat ? DSEQ : SEQ; const int row0 = lat ? NCTXROWS + s * DSEQ : s * SEQ; const int lane = F.lane;
    const bf16* PROJ = (const bf16*)(F.ws + WS_PROJ); bf16* DEC = (bf16*)(F.ws + WS_DEC);
    float S[64];
    if (lat) { const float* sp = gin(F, I_SRWKV) + ((((size_t)s * 4 + l) * 2 + d) * 8 + h) * 4096 + lane * 64;
#pragma unroll
        for (int j = 0; j < 64; j += 4) { const f32x4 v = *(const f32x4*)(sp + j); S[j] = v.x; S[j + 1] = v.y; S[j + 2] = v.z; S[j + 3] = v.w; } }
    else {
#pragma unroll
        for (int j = 0; j < 64; ++j) S[j] = 0.f; }
    const float kkw = gin(F, I_RW_KK)[l * 512 + h * 64 + lane], kaw = gin(F, I_RW_KA)[l * 512 + h * 64 + lane];
    for (int tt = 0; tt < T; ++tt) {
        const int t = d ? T - 1 - tt : tt; const size_t r = (size_t)(row0 + t);
        const float kj = bf2f(PROJ[r * PIN + C_K + h * 64 + lane]), rj = bf2f(PROJ[r * PIN + C_R + h * 64 + lane]), vi = bf2f(PROJ[r * PIN + C_V + h * 64 + lane]);
        const float lw = bf2f(DEC[r * NDEC + d * 512 + h * 64 + lane]), aj = bf2f(DEC[r * NDEC + 1024 + d * 512 + h * 64 + lane]);
        float kk = kj * kkw; const float nrm = wave_sum(kk * kk); kk *= 1.0f / sqrtf(nrm + 1e-12f);
        scr[lane] = kk; scr[64 + lane] = fexp(lw); scr[128 + lane] = kk * aj; scr[192 + lane] = kj * (1.0f + (aj - 1.0f) * kaw); scr[256 + lane] = rj;
        LDS_WAIT(); asm volatile("" ::: "memory");
        float sa0 = 0.f, sa1 = 0.f, sa2 = 0.f, sa3 = 0.f;
#pragma unroll
        for (int j = 0; j < 64; j += 4) { const f32x4 q = *(const LAS f32x4*)(scr + j); sa0 += S[j] * q.x; sa1 += S[j + 1] * q.y; sa2 += S[j + 2] * q.z; sa3 += S[j + 3] * q.w; }
        const float sa = (sa0 + sa1) + (sa2 + sa3);
        float y0 = 0.f, y1 = 0.f, y2 = 0.f, y3 = 0.f;
#pragma unroll
        for (int j = 0; j < 64; j += 4) { const f32x4 w = *(const LAS f32x4*)(scr + 64 + j), b = *(const LAS f32x4*)(scr + 128 + j), kd = *(const LAS f32x4*)(scr + 192 + j), rr = *(const LAS f32x4*)(scr + 256 + j);
            S[j] = S[j] * w.x - sa * b.x + vi * kd.x; S[j + 1] = S[j + 1] * w.y - sa * b.y + vi * kd.y; S[j + 2] = S[j + 2] * w.z - sa * b.z + vi * kd.z; S[j + 3] = S[j + 3] * w.w - sa * b.w + vi * kd.w;
            y0 += S[j] * rr.x; y1 += S[j + 1] * rr.y; y2 += S[j + 2] * rr.z; y3 += S[j + 3] * rr.w; }
        LDS_WAIT(); asm volatile("" ::: "memory");
        DEC[r * NDEC + d * 512 + h * 64 + lane] = (bf16)f2bf((y0 + y1) + (y2 + y3));
    }
    if (!lat) { float* op = F.out + O_SRWKV + ((((size_t)s * 4 + l) * 2 + d) * 8 + h) * 4096 + lane * 64;
#pragma unroll
        for (int j = 0; j < 64; j += 4) *(f32x4*)(op + j) = (f32x4){S[j], S[j + 1], S[j + 2], S[j + 3]}; }
}
__device__ __forceinline__ void lru_scan_naive(Frame& F, int l, int task) {
    const bool lat = task < 64; const int tt0 = lat ? task : task - 64; const int s = tt0 >> 4, d = (tt0 >> 3) & 1, cbk = tt0 & 7;
    const int T = lat ? DSEQ : SEQ; const int row0 = lat ? NCTXROWS + s * DSEQ : s * SEQ; const int c = cbk * 64 + F.lane;
    bf16* LRU = (bf16*)(F.ws + WS_LRU);
    float h = lat ? gin(F, I_SLRU)[(((size_t)s * 4 + l) * 2 + d) * 512 + c] : 0.f;
#pragma unroll 8
    for (int tt = 0; tt < T; ++tt) { const int t = d ? T - 1 - tt : tt; bf16* p = LRU + ((size_t)(row0 + t) * 2 + d) * 1024 + c;
        const float la = bf2f(p[0]), u = bf2f(p[512]); h = fexp(la) * h + u; p[512] = (bf16)f2bf(h); }
    if (!lat) F.out[O_SLRU + (((size_t)s * 4 + l) * 2 + d) * 512 + c] = h;
}
__device__ __forceinline__ void p_scan_naive(Frame& F, int l) {
    LAS float* scr = (LAS float*)(F.lds + RING_OFF + F.wave * 2048);
    const int gwt = F.wave * F.G + F.vcu, NGW = F.G * NWAVES;
    for (int t = gwt; t < 1152; t += NGW) {
        if (t < 64) rwkv_scan_naive(F, l, t, scr);
        else if (t < 128) lru_scan_naive(F, l, t - 64);
        else if (t < 640) rwkv_scan_naive(F, l, t - 128 + 64, scr);
        else lru_scan_naive(F, l, t - 640 + 64);
    }
}
__device__ __forceinline__ void p_bonus(Frame& F, int l, const int gw, const int NGW) {
    const int lane = F.lane; const int c = lane * 8;
    const bf16* PROJ = (const bf16*)(F.ws + WS_PROJ); const bf16* DEC = (const bf16*)(F.ws + WS_DEC); float* BON = (float*)(F.ws + WS_BON);
    float ka[8], rk[8];
    ld8f(gin(F, I_RW_KA) + l * 512 + c, ka); ld8f(gin(F, I_RW_RK) + l * 512 + c, rk);
    for (int r0 = gw; r0 < M; r0 += 2 * NGW) {
        float a0[2][8], a1[2][8], rr[2][8], kk[2][8];
#pragma unroll
        for (int u = 0; u < 2; ++u) { const int r = r0 + u * NGW < M ? r0 + u * NGW : r0; const bf16* pr = PROJ + (size_t)r * PIN; const bf16* dr = DEC + (size_t)r * NDEC;
            ld8(dr + 1024 + c, a0[u]); ld8(dr + 1536 + c, a1[u]); ld8(pr + C_R + c, rr[u]); ld8(pr + C_K + c, kk[u]); }
#pragma unroll
        for (int u = 0; u < 2; ++u) { const int r = r0 + u * NGW; if (r >= M) break; float bs = 0.f;
#pragma unroll
            for (int e = 0; e < 8; ++e) bs += rr[u][e] * kk[u][e] * (2.0f + (a0[u][e] + a1[u][e] - 2.0f) * ka[e]) * rk[e];
            bs = sum8lanes(bs);
            if ((lane & 7) == 0) BON[(size_t)r * 8 + (lane >> 3)] = bs; } }
}
__device__ __forceinline__ void p_combine(Frame& F, int l, const int rlo, const int rhi, const int gw, const int NGW) {
    const int lane = F.lane; const int c = lane * 8;
    const bf16* PROJ = (const bf16*)(F.ws + WS_PROJ); const bf16* DEC = (const bf16*)(F.ws + WS_DEC); const bf16* LRU = (const bf16*)(F.ws + WS_LRU); bf16* CAT = (bf16*)F.out + (size_t)16 * 1024 * 1024;
    float lg[8], lb[8]; const float* BON = (const float*)(F.ws + WS_BON) + (lane >> 3);
    ld8f(gin(F, I_RW_LNXG) + l * 512 + c, lg); ld8f(gin(F, I_RW_LNXB) + l * 512 + c, lb);
    for (int r0 = rlo + gw; r0 < rhi; r0 += 2 * NGW) {
        float y0[2][8], y1[2][8], gg[2][8], vv[2][8], bn[2];
#pragma unroll
        for (int u = 0; u < 2; ++u) { const int r = r0 + u * NGW < rhi ? r0 + u * NGW : r0; const bf16* pr = PROJ + (size_t)r * PIN; const bf16* dr = DEC + (size_t)r * NDEC;
            ld8(dr + c, y0[u]); ld8(dr + 512 + c, y1[u]); ld8(dr + 2048 + c, gg[u]); ld8(pr + C_V + c, vv[u]); bn[u] = *(const GAS float*)(BON + (size_t)r * 8); }
#pragma unroll
        for (int u = 0; u < 2; ++u) { const int r = r0 + u * NGW; if (r >= rhi) break;
            float o[8]; float s = 0.f;
#pragma unroll
            for (int e = 0; e < 8; ++e) { o[e] = y0[u][e] + y1[u][e]; s += o[e]; }
            const float mu = sum8lanes(s) * (1.f / 64.f); const float bonus = bn[u]; float q = 0.f;
#pragma unroll
            for (int e = 0; e < 8; ++e) { o[e] -= mu; q += o[e] * o[e]; }
            const float rstd = __builtin_amdgcn_rsqf(sum8lanes(q) * (1.f / 64.f) + 64e-5f);
            float ya[8];
#pragma unroll
            for (int e = 0; e < 8; ++e) ya[e] = (o[e] * rstd * lg[e] + lb[e] + bonus * vv[u][e]) * gg[u][e];
            v4u w; w.x = pk2(ya[0], ya[1]); w.y = pk2(ya[2], ya[3]); w.z = pk2(ya[4], ya[5]); w.w = pk2(ya[6], ya[7]);
            *(GAS v4u*)(CAT + (size_t)r * D + c) = w; }
    }
}

namespace wkv {
typedef short bf16x8 __attribute__((ext_vector_type(8)));
constexpr int SL_WP = 0, SL_RP = 2304, SL_BKT = 4608, SL_GP = 9728, SL_UU = 11008, SL_GC = 12288, SL_VS = 12544, SLOT_BYTES = 14592;
constexpr int SCR_OFF = 8 * SLOT_BYTES, SCR_BYTES = 9216;
constexpr int SC_XA = 0, SC_XB = 2304, SC_XK = 4608, SC_XR = 6912, SC_LAB = 2304, SC_LAK = 3328, SC_T = 4352;
static_assert(SCR_OFF + 4 * SCR_BYTES <= 155648, "scan LDS map");
struct UnitInfo { int lat, s, d, h, T, row0, N; };
__device__ __forceinline__ UnitInfo unit_info(int u) { UnitInfo q; q.lat = u < 64; const int t = q.lat ? u : u - 64; q.s = t >> 4; q.d = (t >> 3) & 1; q.h = t & 7; q.T = q.lat ? DSEQ : SEQ; q.row0 = q.lat ? NCTXROWS + q.s * DSEQ : q.s * SEQ; q.N = q.T / 16; return q; }
__device__ __forceinline__ int tok_row(const UnitInfo& q, int p) { return q.row0 + (q.d ? q.T - 1 - p : p); }
__device__ __forceinline__ bf16x8 mk8(unsigned a, unsigned b, unsigned c, unsigned d) { const v4u w = {a, b, c, d}; return __builtin_bit_cast(bf16x8, w); }

struct Raw { v4u k[2], r[2], a[2], w[2]; };
__device__ __forceinline__ void prep_load(Raw& R, const bf16* PROJ, const bf16* DEC, const UnitInfo& q, int c, int lane) {
#pragma unroll
    for (int i = 0; i < 2; ++i) { const size_t row = (size_t)tok_row(q, 16 * c + (lane >> 3) + 8 * i); const bf16* pr = PROJ + row * PIN + q.h * 64 + (lane & 7) * 8; const bf16* dr = DEC + row * NDEC + q.d * 512 + q.h * 64 + (lane & 7) * 8;
        R.k[i] = *(const GAS v4u*)(pr + C_K); R.r[i] = *(const GAS v4u*)(pr + C_R); R.w[i] = *(const GAS v4u*)dr; R.a[i] = *(const GAS v4u*)(dr + 1024); }
}
typedef short s16x4 __attribute__((ext_vector_type(4)));
__device__ __forceinline__ v2u trr(const LAS unsigned char* p) { return __builtin_bit_cast(v2u, __builtin_amdgcn_ds_read_tr16_b64_v4i16((LAS s16x4*)p)); }
template <int CTRL> __device__ __forceinline__ float dppx(float x) { return __builtin_bit_cast(float, __builtin_amdgcn_update_dpp(0, __builtin_bit_cast(int, x), CTRL, 0xf, 0xf, false)); }
template <class Reload>
__device__ __forceinline__ void prep_chunk(Raw& R, LAS unsigned char* sl, LAS unsigned char* scr, float kkw, float kaw, int lane, volatile LAS unsigned* flag, unsigned epoch, Reload reload) {
    const int g = lane >> 4, c15 = lane & 15;
#ifdef MK_PSEC
    unsigned long long tq_[8]; tq_[0] = __builtin_amdgcn_s_memrealtime();
#define PMARK(i) LDS_WAIT(); tq_[i] = __builtin_amdgcn_s_memrealtime();
#else
#define PMARK(i)
#endif
#pragma unroll
    for (int i = 0; i < 2; ++i) { const int po = ((lane >> 3) + 8 * i) * 144 + (lane & 7) * 16;
        *(LAS v4u*)(scr + SC_XA + po) = R.k[i]; *(LAS v4u*)(scr + SC_XB + po) = R.a[i]; *(LAS v4u*)(scr + SC_XK + po) = R.w[i]; *(LAS v4u*)(scr + SC_XR + po) = R.r[i]; }
    reload(R);
    PMARK(1)
    v2u kP[4], wP[4], rP[4], aP[4];
    { const LAS unsigned char* tra = scr + ((lane >> 2) & 3) * 144 + ((lane >> 4) * 16 + (lane & 3) * 4) * 2;
#pragma unroll
      for (int T = 0; T < 4; ++T) { kP[T] = trr(tra + SC_XA + 576 * T); wP[T] = trr(tra + SC_XK + 576 * T); }
#pragma unroll
      for (int T = 0; T < 4; ++T) { rP[T] = trr(tra + SC_XR + 576 * T); aP[T] = trr(tra + SC_XB + 576 * T); } }
#define BFT(P, t) (((t) & 1) ? bfhi(((t) & 2) ? P[(t) >> 2].y : P[(t) >> 2].x) : bflo(((t) & 2) ? P[(t) >> 2].y : P[(t) >> 2].x))
    float xk[16], tot = 0.f; float rn[16];
    { float sq[16];
#pragma unroll
      for (int t = 0; t < 16; ++t) { xk[t] = BFT(kP, t) * kkw; sq[t] = xk[t] * xk[t]; tot += BFT(wP, t); }
      float u8[8], v4[4];
#pragma unroll
      for (int i = 0; i < 8; ++i) { const auto rr = __builtin_amdgcn_permlane32_swap(__builtin_bit_cast(unsigned, sq[i]), __builtin_bit_cast(unsigned, sq[i + 8]), false, false);
          u8[i] = __builtin_bit_cast(float, (unsigned)rr[0]) + __builtin_bit_cast(float, (unsigned)rr[1]); }
#pragma unroll
      for (int i = 0; i < 4; ++i) { const auto rr = __builtin_amdgcn_permlane16_swap(__builtin_bit_cast(unsigned, u8[i]), __builtin_bit_cast(unsigned, u8[i + 4]), false, false);
          v4[i] = __builtin_bit_cast(float, (unsigned)rr[0]) + __builtin_bit_cast(float, (unsigned)rr[1]); }
#pragma unroll
      for (int i = 0; i < 4; ++i) { v4[i] += dppx<0x128>(v4[i]); v4[i] += dppx<0x124>(v4[i]); v4[i] += dppx<0x122>(v4[i]); v4[i] += dppx<0x121>(v4[i]); v4[i] = __builtin_amdgcn_rsqf(v4[i] + 1e-12f); }
#pragma unroll
      for (int r = 0; r < 4; ++r)
#pragma unroll
          for (int i = 0; i < 4; ++i) rn[4 * r + i] = __builtin_bit_cast(float, __builtin_amdgcn_readlane(__builtin_bit_cast(int, v4[i]), 16 * r)); }
    const float gC = fexp(tot);
    PMARK(2) PMARK(3)
    unsigned pa[8], pb[8], pkk[8], pr[8]; v4u bkw; float cum = 0.f, eprev = 1.f;
#pragma unroll
    for (int t = 0; t < 16; t += 2) {
        float at[2], bt[2], kt[2], rt[2];
#pragma unroll
        for (int u = 0; u < 2; ++u) { const float kj = BFT(kP, t + u), rj = BFT(rP, t + u), aj = BFT(aP, t + u); cum += BFT(wP, t + u);
            const float ep = fexp(cum), em = __builtin_amdgcn_rcpf(ep); const float kn = xk[t + u] * rn[t + u];
            at[u] = kn * eprev; bt[u] = kn * aj * em; kt[u] = kj * (1.0f + (aj - 1.0f) * kaw) * em; rt[u] = rj * ep; eprev = ep; }
        pa[t >> 1] = pk2(at[0], at[1]); pb[t >> 1] = pk2(bt[0], bt[1]); pkk[t >> 1] = pk2(kt[0], kt[1]); pr[t >> 1] = pk2(rt[0], rt[1]);
        if ((t & 2) == 0) { bkw.x = pk2(bt[0] * gC, bt[1] * gC); bkw.z = pk2(kt[0] * gC, kt[1] * gC); }
        else { bkw.y = pk2(bt[0] * gC, bt[1] * gC); bkw.w = pk2(kt[0] * gC, kt[1] * gC); *(LAS v4u*)(sl + SL_BKT + lane * 80 + (t >> 2) * 16) = bkw; }
    }
    { const int ro = lane * 32;
      *(LAS v4u*)(sl + SL_WP + ro) = (v4u){pa[0], pa[1], pa[2], pa[3]}; *(LAS v4u*)(sl + SL_WP + ro + 16) = (v4u){pa[4], pa[5], pa[6], pa[7]};
      *(LAS v4u*)(sl + SL_RP + ro) = (v4u){pr[0], pr[1], pr[2], pr[3]}; *(LAS v4u*)(sl + SL_RP + ro + 16) = (v4u){pr[4], pr[5], pr[6], pr[7]};
      *(LAS v4u*)(scr + SC_XB + ro) = (v4u){pb[0], pb[1], pb[2], pb[3]}; *(LAS v4u*)(scr + SC_XB + ro + 16) = (v4u){pb[4], pb[5], pb[6], pb[7]};
      *(LAS v4u*)(scr + SC_XK + ro) = (v4u){pkk[0], pkk[1], pkk[2], pkk[3]}; *(LAS v4u*)(scr + SC_XK + ro + 16) = (v4u){pkk[4], pkk[5], pkk[6], pkk[7]}; }
    ((LAS float*)(sl + SL_GC))[lane] = gC;
    PMARK(4)
    f32x4 lab = {0.f, 0.f, 0.f, 0.f}, lak = lab, urb = lab, urk = lab;
    { const int tro = ((lane >> 2) & 3) * 32 + (lane & 3) * 8 + g * 256;
#pragma unroll
      for (int ks = 0; ks < 2; ++ks) { const int off = tro + ks * 1024;
        const v2u a0 = trr(sl + SL_WP + off), a1 = trr(sl + SL_WP + off + 128), b0 = trr(scr + SC_XB + off), b1 = trr(scr + SC_XB + off + 128);
        const v2u k0 = trr(scr + SC_XK + off), k1 = trr(scr + SC_XK + off + 128), r0 = trr(sl + SL_RP + off), r1 = trr(sl + SL_RP + off + 128);
        const bf16x8 fa = mk8(a0.x, a0.y, a1.x, a1.y), fb = mk8(b0.x, b0.y, b1.x, b1.y), fk = mk8(k0.x, k0.y, k1.x, k1.y), fr = mk8(r0.x, r0.y, r1.x, r1.y);
        lab = __builtin_amdgcn_mfma_f32_16x16x32_bf16(fa, fb, lab, 0, 0, 0); lak = __builtin_amdgcn_mfma_f32_16x16x32_bf16(fa, fk, lak, 0, 0, 0);
        urb = __builtin_amdgcn_mfma_f32_16x16x32_bf16(fr, fb, urb, 0, 0, 0); urk = __builtin_amdgcn_mfma_f32_16x16x32_bf16(fr, fk, urk, 0, 0, 0); } }
    { LAS bf16* UU = (LAS bf16*)(sl + SL_UU);
      const int us = 8 * (c15 >> 2) + (c15 & 3);
      f32x4 lt; lt.x = c15 < 4 * g ? lab[0] : 0.f; lt.y = c15 < 4 * g + 1 ? lab[1] : 0.f; lt.z = c15 < 4 * g + 2 ? lab[2] : 0.f; lt.w = c15 < 4 * g + 3 ? lab[3] : 0.f;
      *(LAS f32x4*)(sl + SL_VS + c15 * 64 + g * 16) = lt;
      f32x4 kt_; kt_.x = c15 < 4 * g ? lak[0] : 0.f; kt_.y = c15 < 4 * g + 1 ? lak[1] : 0.f; kt_.z = c15 < 4 * g + 2 ? lak[2] : 0.f; kt_.w = c15 < 4 * g + 3 ? lak[3] : 0.f;
      *(LAS f32x4*)(sl + SL_VS + 1024 + c15 * 64 + g * 16) = kt_;
#pragma unroll
      for (int e = 0; e < 4; ++e) { const int t = 4 * g + e;
          const unsigned wu = pk2(c15 <= t ? urb[e] : 0.f, c15 <= t ? urk[e] : 0.f); UU[t * 40 + us] = (bf16)wu; UU[t * 40 + us + 4] = (bf16)(wu >> 16); } }
    PMARK(5)
#ifdef MK_PSEC
    if (lane == 0) *flag += (unsigned)(tq_[MK_PSEC + 1] - tq_[MK_PSEC]);
#endif
}
__device__ __forceinline__ void sub_chunk(LAS unsigned char* sl, int lane) {
    const int c15 = lane & 15;
    float aw[16], ag[16];
    { const v4u a0 = *(const LAS v4u*)(sl + SL_WP + lane * 32), a1 = *(const LAS v4u*)(sl + SL_WP + lane * 32 + 16);
      aw[0] = bflo(a0.x); aw[1] = bfhi(a0.x); aw[2] = bflo(a0.y); aw[3] = bfhi(a0.y); aw[4] = bflo(a0.z); aw[5] = bfhi(a0.z); aw[6] = bflo(a0.w); aw[7] = bfhi(a0.w);
      aw[8] = bflo(a1.x); aw[9] = bfhi(a1.x); aw[10] = bflo(a1.y); aw[11] = bfhi(a1.y); aw[12] = bflo(a1.z); aw[13] = bfhi(a1.z); aw[14] = bflo(a1.w); aw[15] = bfhi(a1.w);
      const LAS f32x4* KT4 = (const LAS f32x4*)(sl + SL_VS + 1024 + c15 * 64);
#pragma unroll
      for (int q4 = 0; q4 < 4; ++q4) { const f32x4 x = KT4[q4]; ag[4 * q4] = -x.x; ag[4 * q4 + 1] = -x.y; ag[4 * q4 + 2] = -x.z; ag[4 * q4 + 3] = -x.w; } }
    const LAS f32x4* LT4 = (const LAS f32x4*)(sl + SL_VS);
#pragma unroll
    for (int s0 = 0; s0 < 15; ++s0) { f32x4 col[4]; asm volatile("" ::: "memory");
#pragma unroll
        for (int q4 = (s0 + 1) >> 2; q4 < 4; ++q4) col[q4] = LT4[s0 * 4 + q4];
        const float ws = aw[s0], gs = ag[s0];
#pragma unroll
        for (int t = s0 + 1; t < 16; ++t) { const float c = col[t >> 2][t & 3]; aw[t] -= ws * c; ag[t] -= gs * c; } }
    LAS bf16* GP = (LAS bf16*)(sl + SL_GP);
    const int gs_ = 8 * (c15 >> 2) + (c15 & 3) + (lane & 16 ? 4 : 0);
    { v4u w0, w1; w0.x = pk2(-aw[0], -aw[1]); w0.y = pk2(-aw[2], -aw[3]); w0.z = pk2(-aw[4], -aw[5]); w0.w = pk2(-aw[6], -aw[7]);
      w1.x = pk2(-aw[8], -aw[9]); w1.y = pk2(-aw[10], -aw[11]); w1.z = pk2(-aw[12], -aw[13]); w1.w = pk2(-aw[14], -aw[15]);
      *(LAS v4u*)(sl + SL_WP + lane * 32) = w0; *(LAS v4u*)(sl + SL_WP + lane * 32 + 16) = w1; }
#pragma unroll
    for (int t = 0; t < 16; t += 2) { const unsigned wg = lane < 16 ? pk2(ag[t], ag[t + 1]) : 0u;
        if (lane < 32) { GP[t * 40 + gs_] = (bf16)wg; GP[(t + 1) * 40 + gs_] = (bf16)(wg >> 16); } }
}
struct Frags { bf16x8 wp0, wp1, rp0, rp1, gp, uu, bk[4]; f32x4 gc[4]; };
__device__ __forceinline__ void seq_load(Frags& f, const LAS unsigned char* sl, int lane) {
    const int g = lane >> 4, c15 = lane & 15; const int so = c15 * 80 + g * 16;
    const int tro = ((lane >> 2) & 3) * 32 + (lane & 3) * 8 + g * 128;
    f.gp = *(const LAS bf16x8*)(sl + SL_GP + so); f.uu = *(const LAS bf16x8*)(sl + SL_UU + so);
    { const v2u w0 = trr(sl + SL_WP + tro), w1 = trr(sl + SL_WP + tro + 512), w2 = trr(sl + SL_WP + tro + 1024), w3 = trr(sl + SL_WP + tro + 1536);
      const v2u r0 = trr(sl + SL_RP + tro), r1 = trr(sl + SL_RP + tro + 512), r2 = trr(sl + SL_RP + tro + 1024), r3 = trr(sl + SL_RP + tro + 1536);
      f.wp0 = mk8(w0.x, w0.y, w1.x, w1.y); f.wp1 = mk8(w2.x, w2.y, w3.x, w3.y); f.rp0 = mk8(r0.x, r0.y, r1.x, r1.y); f.rp1 = mk8(r2.x, r2.y, r3.x, r3.y); }
#pragma unroll
    for (int jt = 0; jt < 4; ++jt) { f.gc[jt] = *(const LAS f32x4*)(sl + SL_GC + (16 * jt + 4 * g) * 4); f.bk[jt] = *(const LAS bf16x8*)(sl + SL_BKT + (16 * jt + c15) * 80 + g * 16); }
}
template <bool WRITE>
__device__ __forceinline__ void seq_compute(f32x4 (&st)[4], const Frags& f, bf16* DEC, const UnitInfo& q, int c, int slice, int lane, v2u vv) {
    const int g = lane >> 4, c15 = lane & 15;
    const bf16x8 stb0 = mk8(pk2(st[0].x, st[0].y), pk2(st[0].z, st[0].w), pk2(st[1].x, st[1].y), pk2(st[1].z, st[1].w));
    const bf16x8 stb1 = mk8(pk2(st[2].x, st[2].y), pk2(st[2].z, st[2].w), pk2(st[3].x, st[3].y), pk2(st[3].z, st[3].w));
    const bf16x8 vb = mk8(vv.x, vv.y, vv.x, vv.y);
    f32x4 D = {0.f, 0.f, 0.f, 0.f};
    D = __builtin_amdgcn_mfma_f32_16x16x32_bf16(f.gp, vb, D, 0, 0, 0); D = __builtin_amdgcn_mfma_f32_16x16x32_bf16(f.wp0, stb0, D, 0, 0, 0); D = __builtin_amdgcn_mfma_f32_16x16x32_bf16(f.wp1, stb1, D, 0, 0, 0);
    f32x4 Y = {0.f, 0.f, 0.f, 0.f};
    Y = __builtin_amdgcn_mfma_f32_16x16x32_bf16(f.rp0, stb0, Y, 0, 0, 0); Y = __builtin_amdgcn_mfma_f32_16x16x32_bf16(f.rp1, stb1, Y, 0, 0, 0);
    const bf16x8 dv = mk8(pk2(D.x, D.y), pk2(D.z, D.w), vv.x, vv.y);
    Y = __builtin_amdgcn_mfma_f32_16x16x32_bf16(f.uu, dv, Y, 0, 0, 0);
#pragma unroll
    for (int jt = 0; jt < 4; ++jt) st[jt] = __builtin_amdgcn_mfma_f32_16x16x32_bf16(f.bk[jt], dv, st[jt] * f.gc[jt], 0, 0, 0);
    if (WRITE) { bf16* yp = DEC + q.d * 512 + q.h * 64 + 16 * slice + c15 + (size_t)(q.row0 + (q.d ? q.T - 1 - (16 * c + 4 * g) : 16 * c + 4 * g)) * NDEC; const ptrdiff_t st_ = q.d ? -(ptrdiff_t)NDEC : (ptrdiff_t)NDEC;
#pragma unroll
        for (int e = 0; e < 4; ++e) yp[e * st_] = (bf16)f2bf(Y[e]); }
    else { asm volatile("" :: "v"(Y[0]), "v"(Y[1]), "v"(Y[2]), "v"(Y[3])); }
}
__device__ __forceinline__ int wg_unit(int vcu, int k) { if (vcu < 64) return k == 0 ? vcu : -1; const int u = (vcu - 64) + 192 * k; return u < 512 ? 64 + u : -1; }
template <bool WRITE>
__device__ __forceinline__ void scan_phase(Frame& F, int l) {
    int lane0; asm volatile("v_mbcnt_lo_u32_b32 %0, -1, 0\n\tv_mbcnt_hi_u32_b32 %0, -1, %0" : "=v"(lane0)); const int wave = F.wave; const bf16* PROJ = (const bf16*)(F.ws + WS_PROJ); bf16* DEC = (bf16*)(F.ws + WS_DEC);
    int nun = 0; while (nun < 3 && wg_unit(F.vcu, nun) >= 0) ++nun;
    const int cpu = F.vcu < 64 ? 128 : 16, csh = F.vcu < 64 ? 7 : 4;
    const int total = nun * cpu, rounds = total / 4 + 1;
    if (wave >= 4) {
        const int pw = wave - 4; LAS unsigned char* scr = F.lds + SCR_OFF + pw * SCR_BYTES;
        Raw R; UnitInfo q = unit_info(wg_unit(F.vcu, 0));
        float kkw = gin(F, I_RW_KK)[l * 512 + q.h * 64 + lane0], kaw = gin(F, I_RW_KA)[l * 512 + q.h * 64 + lane0];
        if (pw < total) prep_load(R, PROJ, DEC, q, pw, lane0);
        for (int r = 0; r < rounds; ++r) {
            int lane; asm volatile("v_mbcnt_lo_u32_b32 %0, -1, 0\n\tv_mbcnt_hi_u32_b32 %0, -1, %0" : "=v"(lane));
            const int gc = 4 * r + pw, gcn = gc + 4;
            UnitInfo qn = q; float kkwn = kkw, kawn = kaw;
            if (gcn < total && (gcn >> csh) != (gc >> csh)) { qn = unit_info(wg_unit(F.vcu, gcn >> csh)); kkwn = gin(F, I_RW_KK)[l * 512 + qn.h * 64 + lane]; kawn = gin(F, I_RW_KA)[l * 512 + qn.h * 64 + lane]; }
            const unsigned long long tp0_ = MK_TSEL ? __builtin_amdgcn_s_memrealtime() : 0ull;
            if (gc < total) prep_chunk(R, F.lds + (gc & 7) * SLOT_BYTES, scr, kkw, kaw, lane, (volatile LAS unsigned*)(F.lds + MISC_OFF) + (pw == 0 ? 16 : 20), (unsigned)(l * 64 + r + 1), [&](Raw& RR) { if (gcn < total) prep_load(RR, PROJ, DEC, qn, gcn & (cpu - 1), lane); });
#ifndef MK_PSEC
            if (MK_TSEL & 6144) { if (wave == 4 && lane == 0) ((volatile LAS unsigned*)(F.lds + MISC_OFF))[16] += (unsigned)(__builtin_amdgcn_s_memrealtime() - tp0_); }
#endif
            q = qn; kkw = kkwn; kaw = kawn;
            LDS_WAIT(); __builtin_amdgcn_s_barrier(); asm volatile("" ::: "memory");
        }
    } else {
        f32x4 st[4]; UnitInfo q = unit_info(wg_unit(F.vcu, 0));
        unsigned vcur[16], vnxt[16];
        auto vload = [&](unsigned (&vd)[16], int r_, int lane_) {
#pragma unroll
            for (int k4 = 0; k4 < 4; ++k4) { const int gc = 4 * r_ + k4; if (gc < total) { const UnitInfo qq = unit_info(wg_unit(F.vcu, gc >> csh)); const bf16* vp = PROJ + C_V + qq.h * 64 + 16 * wave + (lane_ & 15);
#pragma unroll
                for (int e = 0; e < 4; ++e) vd[4 * k4 + e] = vp[(size_t)tok_row(qq, 16 * (gc & (cpu - 1)) + 4 * (lane_ >> 4) + e) * PIN]; } }
        };
        vload(vnxt, 0, lane0);
        for (int r = 0; r < rounds; ++r) {
            int lane; asm volatile("v_mbcnt_lo_u32_b32 %0, -1, 0\n\tv_mbcnt_hi_u32_b32 %0, -1, %0" : "=v"(lane));
#pragma unroll
            for (int e = 0; e < 16; ++e) vcur[e] = vnxt[e];
            vload(vnxt, r, lane);
            const unsigned long long ts0_ = MK_TSEL ? __builtin_amdgcn_s_memrealtime() : 0ull;
            if (r > 0) {
                Frags fa, fb; const int gc0 = 4 * (r - 1);
                { volatile LAS unsigned* fl = (volatile LAS unsigned*)(F.lds + MISC_OFF) + 24; const unsigned ep = (unsigned)(l * 64 + r + 1);
                  sub_chunk(F.lds + ((gc0 + wave) & 7) * SLOT_BYTES, lane);
                  LDS_WAIT(); fl[wave] = ep;
                  for (;;) { const v4u f4 = *(volatile LAS v4u*)fl; if (__builtin_amdgcn_readfirstlane((f4.x == ep) & (f4.y == ep) & (f4.z == ep) & (f4.w == ep))) break; __builtin_amdgcn_s_sleep(1); }
                  asm volatile("" ::: "memory"); }
                seq_load(fa, F.lds + (gc0 & 7) * SLOT_BYTES, lane);
#pragma unroll
                for (int k4 = 0; k4 < 4; ++k4) { const int gc = gc0 + k4, c = gc & (cpu - 1);
                    Frags& cf = (k4 & 1) ? fb : fa; Frags& nf = (k4 & 1) ? fa : fb;
                    if (k4 < 3) seq_load(nf, F.lds + ((gc + 1) & 7) * SLOT_BYTES, lane);
                    if (c == 0) { q = unit_info(wg_unit(F.vcu, gc >> csh));
                        if (q.lat) { const float* sp = gin(F, I_SRWKV) + ((((size_t)q.s * 4 + l) * 2 + q.d) * 8 + q.h) * 4096 + (size_t)(16 * wave + (lane & 15)) * 64 + 4 * (lane >> 4);
#pragma unroll
                            for (int jt = 0; jt < 4; ++jt) st[jt] = *(const f32x4*)(sp + 16 * jt); }
                        else {
#pragma unroll
                            for (int jt = 0; jt < 4; ++jt) st[jt] = (f32x4){0.f, 0.f, 0.f, 0.f}; } }
                    { v2u vv; vv.x = vcur[4 * k4] | (vcur[4 * k4 + 1] << 16); vv.y = vcur[4 * k4 + 2] | (vcur[4 * k4 + 3] << 16);
                      seq_compute<WRITE>(st, cf, DEC, q, c, wave, lane, vv); }
                    if (WRITE && c == cpu - 1 && !q.lat) { float* op = F.out + O_SRWKV + ((((size_t)q.s * 4 + l) * 2 + q.d) * 8 + q.h) * 4096 + (size_t)(16 * wave + (lane & 15)) * 64 + 4 * (lane >> 4);
#pragma unroll
                        for (int jt = 0; jt < 4; ++jt) *(f32x4*)(op + 16 * jt) = st[jt]; }
                }
            }
            if (MK_TSEL & 6144) { if (wave == 0 && lane == 0) ((volatile LAS unsigned*)(F.lds + MISC_OFF))[17] += (unsigned)(__builtin_amdgcn_s_memrealtime() - ts0_); }
            LDS_WAIT(); __builtin_amdgcn_s_barrier(); asm volatile("" ::: "memory");
        }
    }
}
}
constexpr size_t WS_LAGG = 2 * MiB;
__device__ __forceinline__ void lru_pass1(Frame& F, int task) {
    const int blk = task >> 3, d = (task >> 2) & 1, c = (task & 3) * 128 + 2 * F.lane;
    const bf16* LRU = (const bf16*)(F.ws + WS_LRU) + ((size_t)blk * 64 * 2 + d) * 1024 + c;
    float sla0 = 0.f, sla1 = 0.f, h0 = 0.f, h1 = 0.f;
    unsigned la[2][16], uu[2][16];
#define P1_LD(k, B) { _Pragma("unroll") for (int i = 0; i < 16; ++i) { const int t = d ? 63 - 16 * (k) - i : 16 * (k) + i; la[B][i] = *(const GAS unsigned*)(LRU + (size_t)t * 2048); uu[B][i] = *(const GAS unsigned*)(LRU + (size_t)t * 2048 + 512); } }
    P1_LD(0, 0)
#pragma unroll
    for (int k = 0; k < 4; ++k) {
        if (k < 3) P1_LD(k + 1, (k + 1) & 1)
#pragma unroll
        for (int i = 0; i < 16; ++i) { const float x0 = bflo(la[k & 1][i]), x1 = bfhi(la[k & 1][i]); sla0 += x0; sla1 += x1; h0 = fexp(x0) * h0 + bflo(uu[k & 1][i]); h1 = fexp(x1) * h1 + bfhi(uu[k & 1][i]); } }
#undef P1_LD
    float* A = (float*)(F.ws + WS_LAGG) + ((size_t)blk * 2 + d) * 1024 + c; *(f32x2*)A = (f32x2){sla0, sla1}; *(f32x2*)(A + 512) = (f32x2){h0, h1};
}
__device__ __forceinline__ void lru_pass2(Frame& F, int l, int task) {
    const int blk = task >> 2, c = (task & 3) * 128 + 2 * F.lane;
    const bool lat = blk >= 128; const int s = lat ? (blk - 128) >> 5 : blk >> 2, bi = lat ? (blk - 128) & 31 : blk & 3, nb = lat ? 32 : 4, b0 = blk - bi;
    const float* AG = (const float*)(F.ws + WS_LAGG);
    const bf16* LRU = (const bf16*)(F.ws + WS_LRU) + (size_t)blk * 64 * 2048 + c;
    const bf16* PROJ = (const bf16*)(F.ws + WS_PROJ) + (size_t)blk * 64 * PIN + C_GB + c; bf16* CAT = (bf16*)F.out + (size_t)16 * 1024 * 1024 + (size_t)blk * 64 * D + 512 + c;
    f32x2 h1 = lat ? *(const f32x2*)(gin(F, I_SLRU) + (((size_t)s * 4 + l) * 2 + 1) * 512 + c) : (f32x2){0.f, 0.f};
    for (int bb = nb - 1; bb > bi; bb -= 8) { f32x2 sl[8], hh[8];
#pragma unroll
        for (int i = 0; i < 8; ++i) { const int b = bb - i > bi ? bb - i : bi + 1; const float* a = AG + ((size_t)(b0 + b) * 2 + 1) * 1024 + c; sl[i] = *(const GAS f32x2*)a; hh[i] = *(const GAS f32x2*)(a + 512); }
#pragma unroll
        for (int i = 0; i < 8; ++i) if (bb - i > bi) { h1.x = fexp(sl[i].x) * h1.x + hh[i].x; h1.y = fexp(sl[i].y) * h1.y + hh[i].y; } }
    unsigned hb[64];
    unsigned la[2][8], uu[2][8], gbv[2][8];
#define P2_LD1(k, B) { const bf16* L_ = LRU + (size_t)(63 - 8 * (k)) * 2048 + 1024; asm volatile("" : "+v"(L_)); _Pragma("unroll") for (int i = 0; i < 8; ++i) { la[B][i] = *(const GAS unsigned*)(L_ - (size_t)i * 2048); uu[B][i] = *(const GAS unsigned*)(L_ - (size_t)i * 2048 + 512); } }
#define P2_LD0(k, B) { const bf16* L_ = LRU + (size_t)(8 * (k)) * 2048; const bf16* P_ = PROJ + (size_t)(8 * (k)) * PIN; asm volatile("" : "+v"(L_), "+v"(P_)); _Pragma("unroll") for (int i = 0; i < 8; ++i) { la[B][i] = *(const GAS unsigned*)(L_ + (size_t)i * 2048); uu[B][i] = *(const GAS unsigned*)(L_ + (size_t)i * 2048 + 512); gbv[B][i] = *(const GAS unsigned*)(P_ + (size_t)i * PIN); } }
    P2_LD1(0, 0)
#pragma unroll
    for (int k = 0; k < 8; ++k) {
        if (k < 7) P2_LD1(k + 1, (k + 1) & 1)
#pragma unroll
        for (int i = 0; i < 8; ++i) { const int t = 63 - 8 * k - i; h1.x = fexp(bflo(la[k & 1][i])) * h1.x + bflo(uu[k & 1][i]); h1.y = fexp(bfhi(la[k & 1][i])) * h1.y + bfhi(uu[k & 1][i]); hb[t] = pk2(h1.x, h1.y); } }
    if (!lat && bi == 0) *(f32x2*)(F.out + O_SLRU + (((size_t)s * 4 + l) * 2 + 1) * 512 + c) = h1;
    f32x2 h0 = lat ? *(const f32x2*)(gin(F, I_SLRU) + (((size_t)s * 4 + l) * 2 + 0) * 512 + c) : (f32x2){0.f, 0.f};
    for (int bb = 0; bb < bi; bb += 8) { f32x2 sl[8], hh[8];
#pragma unroll
        for (int i = 0; i < 8; ++i) { const int b = bb + i < bi ? bb + i : bi - 1; const float* a = AG + ((size_t)(b0 + b) * 2 + 0) * 1024 + c; sl[i] = *(const GAS f32x2*)a; hh[i] = *(const GAS f32x2*)(a + 512); }
#pragma unroll
        for (int i = 0; i < 8; ++i) if (bb + i < bi) { h0.x = fexp(sl[i].x) * h0.x + hh[i].x; h0.y = fexp(sl[i].y) * h0.y + hh[i].y; } }
    P2_LD0(0, 0)
#pragma unroll
    for (int k = 0; k < 8; ++k) {
        if (k < 7) P2_LD0(k + 1, (k + 1) & 1)
        bf16* C_ = CAT + (size_t)(8 * k) * D; asm volatile("" : "+v"(C_));
#pragma unroll
        for (int i = 0; i < 8; ++i) { const int t = 8 * k + i; h0.x = fexp(bflo(la[k & 1][i])) * h0.x + bflo(uu[k & 1][i]); h0.y = fexp(bfhi(la[k & 1][i])) * h0.y + bfhi(uu[k & 1][i]);
            *(GAS unsigned*)(C_ + (size_t)i * D) = pk2((h0.x + bflo(hb[t])) * gelu_tanh(bflo(gbv[k & 1][i])), (h0.y + bfhi(hb[t])) * gelu_tanh(bfhi(gbv[k & 1][i]))); } }
#undef P2_LD1
#undef P2_LD0
    if (!lat && bi == nb - 1) *(f32x2*)(F.out + O_SLRU + (((size_t)s * 4 + l) * 2 + 0) * 512 + c) = h0;
}

constexpr int PH_PER_LAYER = 7, PH_PRO = 3, N_PHASES = PH_PRO + DEPTH * PH_PER_LAYER + 1;
__global__ void __launch_bounds__(NWAVES * 64, 2) mk_fwd(Args args) {
    extern __shared__ __attribute__((aligned(16))) unsigned char lds[];
    Frame F;
    F.lds = (LAS unsigned char*)lds;
    F.tid = threadIdx.x; F.lane = F.tid & 63; F.wave = __builtin_amdgcn_readfirstlane(F.tid >> 6);
    F.G = gridDim.x; { const int bx = blockIdx.x; F.vcu = (F.G % 8 == 0) ? (bx % 8) * (F.G / 8) + bx / 8 : bx; }
    F.in = args.in; F.out = args.out; F.ws = args.ws;
    const int vcu0 = F.vcu, G0 = F.G;
    const int wave0 = __builtin_amdgcn_readfirstlane(threadIdx.x >> 6);
    volatile LAS unsigned* MISC = (volatile LAS unsigned*)(F.lds + MISC_OFF);
    for (int u = F.tid; u < (LDS_BYTES - LDSCTL_OFF) / 4; u += NWAVES * 64) ((LAS unsigned*)(F.lds + LDSCTL_OFF))[u] = 0u;
    __syncthreads();
    const int lo = args.ph_lo, hi = args.ph_hi;
    if (hi - lo > 1) (void)xcd_barrier_post((unsigned*)(F.ws + WS_CTL) + CW_BAR, MISC + 8);
    int dup_done = 0;
    unsigned long long t_prev = MK_TSEL ? __builtin_amdgcn_s_memrealtime() : 0ull, t_sel = 0;
    for (int ph = lo; ph < hi; ++ph) {
        { const float* const* in_ = args.in; GAS float* out_ = (GAS float*)args.out; GAS unsigned char* ws_ = (GAS unsigned char*)args.ws; int vcu_ = vcu0, G_ = G0; asm volatile("" : "+s"(out_), "+s"(ws_), "+s"(vcu_), "+s"(G_)); F.in = in_; F.out = (float*)out_; F.ws = (unsigned char*)ws_; F.vcu = vcu_; F.G = G_; }
        { int l_, w_ = wave0; asm volatile("v_mbcnt_lo_u32_b32 %0, -1, 0\n\tv_mbcnt_hi_u32_b32 %0, -1, %0" : "=v"(l_)); asm volatile("" : "+s"(w_)); F.lane = l_; F.wave = w_; F.tid = w_ * 64 + l_; }
        bf16* XN = (bf16*)(F.ws + WS_XN); bf16* PROJ = (bf16*)(F.ws + WS_PROJ); bf16* DEC = (bf16*)(F.ws + WS_DEC); bf16* XN2 = DEC; float* RSS = (float*)(F.ws + WS_RSS); bf16* LRU = (bf16*)(F.ws + WS_LRU); bf16* AUX = LRU; bf16* ACT = PROJ; bf16* XC = (bf16*)F.out; bf16* CAT = (bf16*)F.out + (size_t)16 * 1024 * 1024;
        if (ph == 1000) {
            const bf16* src = (const bf16*)(F.ws + (MK_DBG_BUF == 0 ? WS_PROJ : MK_DBG_BUF == 1 ? WS_DEC : MK_DBG_BUF == 2 ? WS_LRU : WS_XN));
            const size_t gt = (size_t)(F.vcu * NWAVES + F.wave) * 64 + F.lane, NT = (size_t)F.G * NWAVES * 64;
            for (size_t i = gt; i < (size_t)16777216; i += NT) F.out[i] = bf2f(src[i]);
        } else
        if (ph == 0) { if (MK_EN & 1) p0_prologue(F, 0, 1, F.vcu * NWAVES + F.wave, F.G * NWAVES, true, F.G == 256 ? 1 : 0); }
        else if (ph == 1) { if (MK_EN & 2) p1_modreduce(F); }
        else if (ph == 2) { if (MK_EN & 4) p2_prep(F); }
        else if (ph == N_PHASES - 1) { if (MK_EN & 4096) p_finalnorm(F); }
        else {
            const int l = (ph - PH_PRO) / PH_PER_LAYER, s = (ph - PH_PRO) % PH_PER_LAYER;
            const int bidummy = 0; (void)bidummy;
            if (s == 0) { if (MK_EN & 8) {
                pg8::Gemm g{XN, wlayer(F, l, WL_IN), M, PIN, D, D, 0, 0}; pg8::StaticOrder S; S.init(M, PIN, F.G, (int)blockIdx.x);
                pg8::Unit u0; S.next(0, u0); LAS float* rtab = (LAS float*)(F.lds + RTAB_OFF); if (F.tid < 256) rtab[F.tid] = row_rstd(RSS, (size_t)u0.pm * 256 + F.tid); LDS_WAIT(); __syncthreads();
                pg8::EpiProj E{PROJ, AUX, RSS, (const float*)(F.ws + WS_BIAS) + (size_t)l * 5 * PIN, rtab, u0.pm};
                pg8::gemm_phase<pg8::EpiProj, pg8::StaticOrder, true, MK_SP2>(F.lds + RING_OFF, g, S, E, F.tid);
                if (F.G == 256 && (int)blockIdx.x >= 192) { { int l_; asm volatile("v_mbcnt_lo_u32_b32 %0, -1, 0\n\tv_mbcnt_hi_u32_b32 %0, -1, %0" : "=v"(l_)); F.lane = l_; F.tid = F.wave * 64 + l_; }
                    p0_prologue(F, l, 1, ((int)blockIdx.x - 192) * NWAVES + F.wave, 64 * NWAVES, false, 2); }
            } } else if (s == 1) { if (MK_EN & 16) {
                { pg8::Gemm g{AUX, wlayer(F, l, WL_AUX), M, NDEC, 128, NAUX, 128, 3};     pg8::StaticOrder S; S.init(M, NDEC, F.G, (int)blockIdx.x);
                  pg8::EpiDec E{DEC, gin(F, I_RW_W0) + l * 1024, gin(F, I_RW_A0) + l * 1024};
                  const unsigned long long tg0_ = MK_TSEL ? __builtin_amdgcn_s_memrealtime() : 0ull;
                  pg8::gemm_phase<pg8::EpiDec, pg8::StaticOrder, true, MK_SP2>(F.lds + RING_OFF, g, S, E, F.tid);
                  if ((MK_TSEL >> 16) & 1) t_sel += __builtin_amdgcn_s_memrealtime() - tg0_; }
                if (F.G == 256) { if ((int)blockIdx.x >= 128) p_lruconv_chunks(F, l, ((int)blockIdx.x - 128) * 16, 16); } else p_lruconv(F, l);
            } } else if (s == 2) { if (MK_EN & 64) {
#if MK_DRYSCAN
                wkv::scan_phase<false>(F, l); { XcdBarrier b_; b_.bar = (unsigned*)(F.ws + WS_CTL) + CW_BAR; b_.x = xb_xcc_id(); b_.st = MISC + 8; xcd_barrier(b_, F.tid == 0); }
#endif
                if (F.vcu >= 64) {
                    pg8::Gemm g{XC, wlayer(F, l, WL_LRU), M, NLRU, 128, 512, 128, 1};     pg8::StaticOrder S; S.init(M, NLRU, 192, F.vcu < 192 ? F.vcu : F.vcu - 192);
                    pg8::EpiLru E{LRU, XC, gin(F, I_LRU_GAB) + l * 1024, gin(F, I_LRU_GXB) + l * 1024, (const float*)(F.ws + WS_SPT) + l * 1024};
                    const unsigned long long tl0_ = MK_TSEL ? __builtin_amdgcn_s_memrealtime() : 0ull;
                    pg8::gemm_phase<pg8::EpiLru, pg8::StaticOrder, true, MK_SP2>(F.lds + RING_OFF, g, S, E, F.tid);
                    if ((MK_TSEL >> 21) & 1) t_sel += __builtin_amdgcn_s_memrealtime() - tl0_;
                    unsigned* subc = (unsigned*)(F.ws + WS_CTL) + CW_SUB + 64 * l;
                    asm volatile("s_waitcnt vmcnt(0)" ::: "memory"); __syncthreads();
                    if (F.tid == 0) { __builtin_amdgcn_fence(__ATOMIC_RELEASE, "agent"); asm volatile("s_waitcnt vmcnt(0)" ::: "memory"); (void)xb_add(subc, 1u); }
                }
                { const unsigned long long t0_ = MK_TSEL ? __builtin_amdgcn_s_memrealtime() : 0ull; const unsigned long long c0_ = MK_TSEL ? __builtin_amdgcn_s_memtime() : 0ull;
                wkv::scan_phase<true>(F, l);
                if ((MK_TSEL >> 15) & 1) t_sel += (__builtin_amdgcn_s_memtime() - c0_) >> 6;
                { int l_; asm volatile("v_mbcnt_lo_u32_b32 %0, -1, 0\n\tv_mbcnt_hi_u32_b32 %0, -1, %0" : "=v"(l_)); F.lane = l_; F.tid = F.wave * 64 + l_; }
                if ((MK_TSEL >> 10) & 1) t_sel += __builtin_amdgcn_s_memrealtime() - t0_; }
                if (F.vcu >= 64) { unsigned* subc = (unsigned*)(F.ws + WS_CTL) + CW_SUB + 64 * l;
                    const unsigned long long tl1_ = MK_TSEL ? __builtin_amdgcn_s_memrealtime() : 0ull;
                    if (F.tid == 0) { unsigned sp_ = 0; while (xb_ld(subc) < 192u) { __builtin_amdgcn_s_sleep(2); if (++sp_ > (1u << 22)) break; }
                        __builtin_amdgcn_fence(__ATOMIC_ACQUIRE, "agent"); asm volatile("s_waitcnt vmcnt(0)" ::: "memory"); }
                    __syncthreads();
                    const unsigned long long tl2_ = MK_TSEL ? __builtin_amdgcn_s_memrealtime() : 0ull; if ((MK_TSEL >> 22) & 1) t_sel += tl2_ - tl1_;
                    { const int gw = (F.vcu < 192 ? F.vcu : F.vcu - 192) * NWAVES + F.wave; for (int t = gw; t < 2048; t += 192 * NWAVES) lru_pass1(F, t); }
                    if ((MK_TSEL >> 23) & 1) { asm volatile("s_waitcnt vmcnt(0)" ::: "memory"); t_sel += __builtin_amdgcn_s_memrealtime() - tl2_; }
                    p_bonus(F, l, (F.vcu - 64) * NWAVES + F.wave, 192 * NWAVES); }
            } }
            else if (s == 3) { if (MK_EN & 128) {
                if (F.G == 256) { if (F.wave < 4) lru_pass2(F, l, F.vcu * 4 + F.wave);
                    const int base = F.vcu * 64 + (F.wave < 4 ? F.wave * 4 : 16 + (F.wave - 4) * 12); p_combine(F, l, base, base + (F.wave < 4 ? 4 : 12), 0, 1); }
                else { { const int gw = F.vcu * NWAVES + F.wave; for (int t = gw; t < 1024; t += F.G * NWAVES) lru_pass2(F, l, t); }
                    p_combine(F, l, 0, M, F.vcu * NWAVES + F.wave, F.G * NWAVES); } } }
            else if (s == 4) { if (MK_EN & 256) {
                pg8::Gemm g{CAT, wlayer(F, l, WL_OUT), M, D, D, D, 0, 0}; pg8::StaticOrder S; S.init(M, D, F.G, (int)blockIdx.x);
                pg8::EpiRes E{gin(F, I_XP), gin(F, I_XS), (const bf16*)XN, (float*)nullptr, (bf16*)nullptr  , modp(F, l, 0) + 2048, XN2, gin(F, I_LN2G) + l * D, modp(F, l, 0) + 4096, RSS, (PG8_LAS float*)(F.lds + XBUF_OFF), gin(F, I_LN1G) + l * D, modp(F, l, 0) + 1024};
                pg8::gemm_phase<pg8::EpiRes, pg8::StaticOrder, true, MK_SP2>(F.lds + RING_OFF, g, S, E, F.tid);
            } } else if (s == 5) { if (MK_EN & 1024) { const unsigned long long cg0_ = MK_TSEL ? __builtin_amdgcn_s_memtime() : 0ull; const unsigned long long rg0_ = MK_TSEL ? __builtin_amdgcn_s_memrealtime() : 0ull;
                pg8::Gemm g{XN2, wlayer(F, l, WL_UP), M, 2 * DFF, D, D, 0, 0}; pg8::StaticOrder S; S.init(M, 2 * DFF, F.G, (int)blockIdx.x);
                pg8::Unit u0; S.next(0, u0); LAS float* rtab = (LAS float*)(F.lds + RTAB_OFF); if (F.tid < 256) rtab[F.tid] = row_rstd(RSS, (size_t)u0.pm * 256 + F.tid); LDS_WAIT(); __syncthreads();
                pg8::EpiFfn E{ACT, gin(F, I_FCW) + (size_t)l * 3 * 5632, gin(F, I_FCB) + (size_t)l * 5632, (PG8_LAS float*)(F.lds + XBUF_OFF), RSS, (const float*)(F.ws + WS_BIAS) + BIAS_UP_OFF + (size_t)l * 5 * 5632, rtab, u0.pm, (volatile PG8_LAS unsigned*)(F.lds + MISC_OFF) + 18};
                pg8::gemm_phase<pg8::EpiFfn, pg8::StaticOrder, true, MK_SP2>(F.lds + RING_OFF, g, S, E, F.tid);
                if (l + 1 < DEPTH && (int)blockIdx.x >= F.G / 2) { const int wi = (int)blockIdx.x - F.G / 2, nw = F.G - F.G / 2; p0_prologue(F, l + 1, 1, wi * NWAVES + F.wave, nw * NWAVES, false, F.G == 256 ? 1 : 0); LDS_WAIT(); __syncthreads(); bias_tables(F, l + 1, wi, nw); }
                if ((MK_TSEL >> 18) & 1) t_sel += (__builtin_amdgcn_s_memtime() - cg0_) >> 6;
                if ((MK_TSEL >> 19) & 1) t_sel += __builtin_amdgcn_s_memrealtime() - rg0_;
            } } else { if (MK_EN & 2048) {
                const int ln = l + 1 < DEPTH ? l + 1 : l;
                pg8::Gemm g{ACT, wlayer(F, l, WL_DOWN), M, D, DFF, DFF, 0, 0}; pg8::StaticOrder S; S.init(M, D, F.G, (int)blockIdx.x);
                pg8::EpiRes E{F.out, F.out + (size_t)NCTXROWS * D, (const bf16*)XN2, (float*)nullptr, (bf16*)nullptr, modp(F, l, 0) + 5120, XN, l + 1 < DEPTH ? gin(F, I_LN1G) + ln * D : gin(F, I_LNFG), l + 1 < DEPTH ? modp(F, ln, 0) + 1024 : (const float*)nullptr, RSS, (PG8_LAS float*)(F.lds + XBUF_OFF), gin(F, I_LN2G) + l * D, modp(F, l, 0) + 4096};
                pg8::gemm_phase<pg8::EpiRes, pg8::StaticOrder, true, MK_SP2>(F.lds + RING_OFF, g, S, E, F.tid);
            } }
        }
        { const unsigned long long tb0_ = ((MK_TSEL >> 20) & 1) ? __builtin_amdgcn_s_memrealtime() : 0ull;
        if (ph + 1 < hi) { XcdBarrier b_; b_.bar = (unsigned*)(F.ws + WS_CTL) + CW_BAR; b_.x = xb_xcc_id(); b_.st = MISC + 8; xcd_barrier(b_, F.tid == 0); }
        if ((MK_TSEL >> 20) & 1) { const int bc_ = ph == 0 ? 8 : ph == 1 ? 13 : ph == 2 ? 14 : (ph == N_PHASES - 1 ? 9 : (ph - PH_PRO) % PH_PER_LAYER); if (MK_BCLS < 0 || bc_ == MK_BCLS) t_sel += __builtin_amdgcn_s_memrealtime() - tb0_; } }
        if (MK_TSEL) { const unsigned long long t_now = __builtin_amdgcn_s_memrealtime(); const int cls = ph == 0 ? 8 : ph == 1 ? 13 : ph == 2 ? 14 : (ph == N_PHASES - 1 ? 9 : (ph - PH_PRO) % PH_PER_LAYER); if ((MK_TSEL >> cls) & 1) t_sel += t_now - t_prev; t_prev = t_now; }
        if ((MK_DUP & 1024) && ph + 1 < hi) { XcdBarrier b_; b_.bar = (unsigned*)(F.ws + WS_CTL) + CW_BAR; b_.x = xb_xcc_id(); b_.st = MISC + 8; xcd_barrier(b_, F.tid == 0); }
        if ((MK_DUP & 1023) && ph >= PH_PRO && ph + 1 < N_PHASES - 1 && ph + 1 < hi) { const int s_ = (ph - PH_PRO) % PH_PER_LAYER; if (((MK_DUP >> s_) & 1) && !dup_done) { dup_done = 1; --ph; } else dup_done = 0; }
    }
    if ((MK_TSEL >> 17) & 1) t_sel += MISC[18];
    if ((MK_TSEL >> 24) & 1 || (MK_TSEL >> 27) & 1) t_sel += MISC[19];
    if ((MK_TSEL >> 26) & 1) t_sel += MISC[22];
    if ((MK_TSEL >> 25) & 1) t_sel += MISC[21];
    if ((MK_TSEL >> 11) & 1) t_sel += MISC[16];
    if ((MK_TSEL >> 12) & 1) t_sel += MISC[17];
    if (MK_TSEL && blockIdx.x == MK_TBLK) { const unsigned long long t_end = __builtin_amdgcn_s_memrealtime() + MK_TMUL * t_sel; while (__builtin_amdgcn_s_memrealtime() < t_end) __builtin_amdgcn_s_sleep(32); }
}

extern "C" void kernel_launch(void* const* d_in, const int* in_sizes, int n_in, void* d_out, int out_size, void* d_ws, size_t ws_size, hipStream_t stream) {
    static int grid = 0;
    if (grid == 0) {
        if (n_in != N_IN || (size_t)out_size != OUT_TOTAL || ws_size < WS_END) { fprintf(stderr, "kernel_launch: unexpected shapes: n_in %d out %d ws %zu\n", n_in, out_size, ws_size); grid = -1; return; }
        int dev = 0, cus = 0;
        if (hipGetDevice(&dev) != hipSuccess || hipDeviceGetAttribute(&cus, hipDeviceAttributeMultiprocessorCount, dev) != hipSuccess) { grid = -1; return; }
        if (hipFuncSetAttribute((const void*)mk_fwd, hipFuncAttributeMaxDynamicSharedMemorySize, LDS_BYTES) != hipSuccess) { grid = -1; return; }
        (void)hipGetLastError();
        grid = cus;
    }
    if (grid < 0) return;
    (void)hipMemsetAsync((char*)d_ws + WS_CTL, 0, CTL_ZERO_BYTES, stream);
    Args a{};
    for (int i = 0; i < N_IN; ++i) a.in[i] = (const float*)d_in[i];
    a.out = (float*)d_out; a.ws = (unsigned char*)d_ws;
#if MK_ONE_LAUNCH
    a.ph_lo = 0; a.ph_hi = N_PHASES;
    hipLaunchKernelGGL(mk_fwd, dim3(grid), dim3(NWAVES * 64), LDS_BYTES, stream, a);
#else
    const int nph = MK_DBG_STOP ? MK_DBG_STOP : N_PHASES;
    for (int ph = 0; ph < nph; ++ph) { a.ph_lo = ph; a.ph_hi = ph + 1; hipLaunchKernelGGL(mk_fwd, dim3(grid), dim3(NWAVES * 64), LDS_BYTES, stream, a); }
    if (MK_DBG_STOP) { a.ph_lo = 1000; a.ph_hi = 1001; hipLaunchKernelGGL(mk_fwd, dim3(grid), dim3(NWAVES * 64), LDS_BYTES, stream, a); }
#endif
}
```
